# Optimizing an MI355X kernel written in HIP

```python
import math
import jax, jax.numpy as jnp
from jax import lax
import numpy as np

D_MODEL = 1024
BATCH = 8
SEQ = 4096
DEPTH = 1

CHUNK = 64
D_MIX = D_MODEL
S5_WIDTH = D_MIX // 2
S5_GROUP_CH = 16
S5_GROUPS = S5_WIDTH // S5_GROUP_CH
S5_STATE = 64
CONV_WIDTH = D_MIX - S5_WIDTH
CONV_HEAD_DIM = 64
CONV_HEADS = CONV_WIDTH // CONV_HEAD_DIM
CONV_K = 31
D_FF = 2816
IN_COLS = S5_WIDTH + 2 * CONV_WIDTH
EPS = 1e-6

kernel_name = "hybrid_s5_conformer_conv_macaron"


def rms_norm(x, g):
    xf = x.astype(jnp.float32)
    y = xf * lax.rsqrt(jnp.mean(xf * xf, axis=-1, keepdims=True) + EPS)
    return (y * g.astype(jnp.float32)).astype(x.dtype)


def swiglu_ffn(h, w_gate, w_up, w_down):
    return (jax.nn.silu(h @ w_gate) * (h @ w_up)) @ w_down


def _complex_affine_combine(left, right):
    a_re_i, a_im_i, b_re_i, b_im_i = left
    a_re_j, a_im_j, b_re_j, b_im_j = right
    a_re = a_re_j * a_re_i - a_im_j * a_im_i
    a_im = a_re_j * a_im_i + a_im_j * a_re_i
    b_re = a_re_j * b_re_i - a_im_j * b_im_i + b_re_j
    b_im = a_re_j * b_im_i + a_im_j * b_re_i + b_im_j
    return (a_re, a_im, b_re, b_im)


def s5_mixer(u, lam_re, lam_im, log_dt, b_re, b_im, c_re, c_im, d_skip, w_glu, b_glu):
    bsz, seq_len, _ = u.shape
    uf = u.astype(jnp.float32).reshape(bsz, seq_len, S5_GROUPS, S5_GROUP_CH)
    lr = lam_re.astype(jnp.float32)
    li = lam_im.astype(jnp.float32)
    dt = jnp.exp(log_dt.astype(jnp.float32))[:, None]
    mag = jnp.exp(lr * dt)
    abar_re = mag * jnp.cos(li * dt)
    abar_im = mag * jnp.sin(li * dt)
    den = lr * lr + li * li
    num_re = abar_re - 1.0
    num_im = abar_im
    f_re = ((num_re * lr + num_im * li) / den)[..., None]
    f_im = ((num_im * lr - num_re * li) / den)[..., None]
    br = b_re.astype(jnp.float32)
    bi = b_im.astype(jnp.float32)
    bbar_re = f_re * br - f_im * bi
    bbar_im = f_re * bi + f_im * br
    bu_re = jnp.einsum('blgc,gpc->blgp', uf, bbar_re)
    bu_im = jnp.einsum('blgc,gpc->blgp', uf, bbar_im)
    a_re = jnp.broadcast_to(abar_re[None, None], (1, seq_len, S5_GROUPS, S5_STATE))
    a_im = jnp.broadcast_to(abar_im[None, None], (1, seq_len, S5_GROUPS, S5_STATE))
    _, _, s_re, s_im = lax.associative_scan(_complex_affine_combine,
                                            (a_re, a_im, bu_re, bu_im), axis=1)
    y = (jnp.einsum('blgp,gcp->blgc', s_re, c_re.astype(jnp.float32))
         - jnp.einsum('blgp,gcp->blgc', s_im, c_im.astype(jnp.float32)))
    y = y + d_skip.astype(jnp.float32).reshape(S5_GROUPS, S5_GROUP_CH) * uf
    y = jax.nn.gelu(y.reshape(bsz, seq_len, S5_WIDTH)).astype(u.dtype)
    return y * jax.nn.sigmoid(y @ w_glu + b_glu)


def conv_module_mixer(v, w_dw, b_dw, ln_g, ln_b):
    bsz, seq_len, _ = v.shape
    z = v[..., :CONV_WIDTH] * jax.nn.sigmoid(v[..., CONV_WIDTH:])
    z = lax.conv_general_dilated(
        z, w_dw[:, None, :], window_strides=(1,), padding=[(CONV_K - 1, 0)],
        dimension_numbers=('NWC', 'WIO', 'NWC'), feature_group_count=CONV_WIDTH) + b_dw
    zf = z.astype(jnp.float32).reshape(bsz, seq_len, CONV_HEADS, CONV_HEAD_DIM)
    mu = jnp.mean(zf, axis=-1, keepdims=True)
    var = jnp.mean(jnp.square(zf - mu), axis=-1, keepdims=True)
    zn = ((zf - mu) * lax.rsqrt(var + EPS)).reshape(bsz, seq_len, CONV_WIDTH)
    zn = zn * ln_g.astype(jnp.float32) + ln_b.astype(jnp.float32)
    return jax.nn.silu(zn).astype(v.dtype)


def setup_inputs(seed: int = 0) -> dict:
    key = jax.random.key(seed)
    ks = jax.random.split(key, 32)
    f32 = jnp.float32

    def nrm(k, shape, scale):
        return jax.random.normal(k, shape, f32) * scale

    def gain(k, shape):
        return 1.0 + 0.02 * jax.random.normal(k, shape, f32)

    L = DEPTH
    n_idx = jnp.arange(S5_STATE, dtype=f32)
    lam_re = -0.5 * (1.0 + 0.05 * jax.random.normal(ks[10], (L, S5_GROUPS, S5_STATE), f32))
    lam_im = jnp.broadcast_to(math.pi * n_idx, (L, S5_GROUPS, S5_STATE)) \
        + 0.01 * jax.random.normal(ks[11], (L, S5_GROUPS, S5_STATE), f32)
    log_dt = jax.random.uniform(ks[12], (L, S5_GROUPS), f32, math.log(1e-3), math.log(1e-1))
    return {
        "x": jax.random.normal(ks[0], (BATCH, SEQ, D_MODEL), f32),
        "ffn1_norm": gain(ks[1], (L, D_MODEL)),
        "ffn1_w_gate": nrm(ks[2], (L, D_MODEL, D_FF), D_MODEL ** -0.5),
        "ffn1_w_up": nrm(ks[3], (L, D_MODEL, D_FF), D_MODEL ** -0.5),
        "ffn1_w_down": nrm(ks[4], (L, D_FF, D_MODEL), D_FF ** -0.5),
        "mix_norm": gain(ks[5], (L, D_MODEL)),
        "w_in": nrm(ks[6], (L, D_MODEL, IN_COLS), D_MODEL ** -0.5),
        "s5_lam_re": lam_re,
        "s5_lam_im": lam_im,
        "s5_log_dt": log_dt,
        "s5_b_re": nrm(ks[13], (L, S5_GROUPS, S5_STATE, S5_GROUP_CH), (2 * S5_GROUP_CH) ** -0.5),
        "s5_b_im": nrm(ks[14], (L, S5_GROUPS, S5_STATE, S5_GROUP_CH), (2 * S5_GROUP_CH) ** -0.5),
        "s5_c_re": nrm(ks[15], (L, S5_GROUPS, S5_GROUP_CH, S5_STATE), (2 * S5_STATE) ** -0.5),
        "s5_c_im": nrm(ks[16], (L, S5_GROUPS, S5_GROUP_CH, S5_STATE), (2 * S5_STATE) ** -0.5),
        "s5_d": gain(ks[17], (L, S5_WIDTH)),
        "s5_w_glu": nrm(ks[18], (L, S5_WIDTH, S5_WIDTH), S5_WIDTH ** -0.5),
        "s5_b_glu": nrm(ks[19], (L, S5_WIDTH), 0.02),
        "conv_w_dw": nrm(ks[20], (L, CONV_K, CONV_WIDTH), CONV_K ** -0.5),
        "conv_b_dw": nrm(ks[21], (L, CONV_WIDTH), 0.02),
        "conv_ln_g": gain(ks[22], (L, CONV_WIDTH)),
        "conv_ln_b": nrm(ks[23], (L, CONV_WIDTH), 0.02),
        "w_out": nrm(ks[24], (L, D_MIX, D_MODEL), D_MIX ** -0.5),
        "ffn2_norm": gain(ks[25], (L, D_MODEL)),
        "ffn2_w_gate": nrm(ks[26], (L, D_MODEL, D_FF), D_MODEL ** -0.5),
        "ffn2_w_up": nrm(ks[27], (L, D_MODEL, D_FF), D_MODEL ** -0.5),
        "ffn2_w_down": nrm(ks[28], (L, D_FF, D_MODEL), D_FF ** -0.5),
        "final_norm": gain(ks[29], (D_MODEL,)),
    }


def reference(x, ffn1_norm, ffn1_w_gate, ffn1_w_up, ffn1_w_down, mix_norm, w_in,
              s5_lam_re, s5_lam_im, s5_log_dt, s5_b_re, s5_b_im, s5_c_re, s5_c_im,
              s5_d, s5_w_glu, s5_b_glu, conv_w_dw, conv_b_dw, conv_ln_g, conv_ln_b,
              w_out, ffn2_norm, ffn2_w_gate, ffn2_w_up, ffn2_w_down, final_norm):
    for l in range(DEPTH):
        h = rms_norm(x, ffn1_norm[l])
        x = x + 0.5 * swiglu_ffn(h, ffn1_w_gate[l], ffn1_w_up[l], ffn1_w_down[l])
        h = rms_norm(x, mix_norm[l])
        u = h @ w_in[l]
        y_s5 = s5_mixer(u[..., :S5_WIDTH], s5_lam_re[l], s5_lam_im[l], s5_log_dt[l],
                        s5_b_re[l], s5_b_im[l], s5_c_re[l], s5_c_im[l], s5_d[l],
                        s5_w_glu[l], s5_b_glu[l])
        y_conv = conv_module_mixer(u[..., S5_WIDTH:], conv_w_dw[l], conv_b_dw[l],
                                   conv_ln_g[l], conv_ln_b[l])
        x = x + jnp.concatenate([y_s5, y_conv], axis=-1) @ w_out[l]
        h = rms_norm(x, ffn2_norm[l])
        x = x + 0.5 * swiglu_ffn(h, ffn2_w_gate[l], ffn2_w_up[l], ffn2_w_down[l])
    return rms_norm(x, final_norm)
```

```cpp
#include <hip/hip_runtime.h>
#include <hip/hip_cooperative_groups.h>
#include <cstdio>
#include <cstdint>
namespace cg = cooperative_groups;

#ifndef GU_WGM
#define GU_WGM 4
#endif
#ifndef DBG_STOP
#define DBG_STOP 0
#endif
#ifndef MK_MULTI
#define MK_MULTI 0
#endif

namespace pg8 {
#define PG8_LAS __attribute__((address_space(3)))
typedef unsigned short bf16_t;
typedef short bf16x8 __attribute__((ext_vector_type(8)));
typedef float f32x4 __attribute__((ext_vector_type(4)));
typedef unsigned u32x4 __attribute__((ext_vector_type(4)));
constexpr int BM = 256, BK = 64, HALF = 128, HTB = HALF * BK * 2  , STAGE_BYTES = 8 * HTB, NXCD = 8, WGM = 8;

__host__ __device__ __forceinline__ int lds_byte(int r, int c) { const int st = (r >> 4) * 2 + (c >> 5), rr = r & 15, cc = c & 31, ob = rr * 64 + cc * 2; return st * 1024 + (ob ^ (((ob >> 9) & 1) << 5)); }
__host__ __device__ __forceinline__ void stage_rc(int b, int& R, int& C) { const int st = b / 1024, sb = b % 1024, swz = sb ^ (((sb >> 9) & 1) << 5); R = (st >> 1) * 16 + swz / 64; C = (st & 1) * 32 + (swz % 64) / 2; }
__host__ __device__ __forceinline__ int perm32(int rho) { const int n = rho >> 4, i = rho & 15; return 8 * (i >> 2) + 4 * n + (i & 3); }

struct Unit { int pm, pn; };
struct Gemm { const bf16_t* A; const bf16_t* Bt; int M, N, K; };

struct StaticOrder {
    int nM, nN, nwg, G, c, wgm, rev;
    __host__ __device__ void init(int M, int N, int G_, int c_, int wgm_ = WGM, int rev_ = 0) { nM = M / BM; nN = N / BM; nwg = nM * nN; G = G_; c = c_; wgm = wgm_; rev = rev_; }
    __host__ __device__ bool next(int i, Unit& u) const {
        const int nr = nwg / G; const bool rv = rev && (nwg % G == 0);
        const long L = (long)((rv && i < nr) ? nr - 1 - i : i) * G + c; if (L >= nwg) return false;
        int wgid = (int)L; { const int q = nwg / NXCD, r = nwg % NXCD, xcd = wgid % NXCD, off = wgid / NXCD; wgid = (xcd < r ? xcd * (q + 1) : r * (q + 1) + (xcd - r) * q) + off; }
        const int nig = wgm * nN, gid = wgid / nig, fm = gid * wgm, gsz = (nM - fm) < wgm ? (nM - fm) : wgm;
        u.pm = fm + ((wgid % nig) % gsz); u.pn = (wgid % nig) / gsz; return true;
    }
    __device__ __forceinline__ void a_ready(const Unit&) const {}
    __device__ __forceinline__ void done(const Unit&) const {}
};

typedef __bf16 bf16v2_t __attribute__((ext_vector_type(2)));
typedef float f32v2_t __attribute__((ext_vector_type(2)));
__device__ __forceinline__ unsigned cvt_pk_bf16(float lo, float hi) { const f32v2_t f = {lo, hi}; const bf16v2_t r = __builtin_convertvector(f, bf16v2_t); return __builtin_bit_cast(unsigned, r); }
typedef float f32x2 __attribute__((ext_vector_type(2)));
typedef unsigned u32x2 __attribute__((ext_vector_type(2)));
template <class Epi, class Sched, bool ALIGN_EPI = false, bool SP2 = false>
__device__ __forceinline__ void gemm_phase(PG8_LAS unsigned char* lds, const Gemm g, const Sched& S, const Epi& E) {
    const int tid = threadIdx.x, wid = __builtin_amdgcn_readfirstlane(tid >> 6), lane = tid & 63, wr = wid >> 2, wc = wid & 3, fr = lane & 15, fq = lane >> 4;
    const int K = g.K, nt = K / BK;
    unsigned voffA[2], voffB[2];
#pragma unroll
    for (int i = 0; i < 2; ++i) { int R, C; stage_rc(tid * 16 + i * 8192, R, C); const int Rb = Epi::PERM ? ((R & ~31) + perm32(R & 31)) : R;
        voffA[i] = (unsigned)(R * K + C) * 2u; voffB[i] = (unsigned)(Rb * K + C) * 2u; }
    const size_t kstep = (size_t)(BK * 2);
    const size_t hstep = (size_t)HALF * K * 2;
    const size_t tstep = 2 * hstep;
    const unsigned ldsw = (unsigned)wid * 1024u;
    const int aoff = lds_byte(wr * 64 + fr, fq * 8), boff = lds_byte(wc * 32 + fr, fq * 8);
#define PG8_SA(b, h) (((b) * 2 + (h)) * HTB)
#define PG8_SB(b, h) ((4 + (b) * 2 + (h)) * HTB)
#define PG8_STAGE(bufoff, gbase, voff) do { _Pragma("unroll") for (int _i = 0; _i < 2; ++_i) \
        __builtin_amdgcn_global_load_lds((const unsigned*)((const char*)(gbase) + (voff)[_i]), (PG8_LAS unsigned*)(lds + (bufoff) + ldsw + _i * 8192), 16, 0, 0); } while (0)
#define PG8_LDA(dst, b, h) do { _Pragma("unroll") for (int m = 0; m < 4; ++m) _Pragma("unroll") for (int k = 0; k < 2; ++k) dst[m][k] = *(const PG8_LAS bf16x8*)(lds + PG8_SA(b, h) + aoff + m * 2048 + k * 1024); } while (0)
#define PG8_LDB(dst, b, h) do { _Pragma("unroll") for (int n = 0; n < 2; ++n) _Pragma("unroll") for (int k = 0; k < 2; ++k) dst[n][k] = *(const PG8_LAS bf16x8*)(lds + PG8_SB(b, h) + boff + n * 2048 + k * 1024); } while (0)
#define PG8_MMA(ai, bj, At, Bt) do { __builtin_amdgcn_s_setprio(1); _Pragma("unroll") for (int m = 0; m < 4; ++m) _Pragma("unroll") for (int n = 0; n < 2; ++n) _Pragma("unroll") for (int k = 0; k < 2; ++k) \
        acc[ai][bj][m][n] = __builtin_amdgcn_mfma_f32_16x16x32_bf16(Bt[n][k], At[m][k], acc[ai][bj][m][n], 0, 0, 0); __builtin_amdgcn_s_setprio(0); } while (0)
#define PG8_WAIT_V(n) asm volatile("s_waitcnt vmcnt(" #n ")" ::: "memory")
#define PG8_WAIT_L(n) asm volatile("s_waitcnt lgkmcnt(" #n ")" ::: "memory")
#define PG8_BAR __builtin_amdgcn_s_barrier()
#define PG8_SCHED __builtin_amdgcn_sched_barrier(0)
    Unit cur, nxt; int ui = 0;
    if (!S.next(0, cur)) return;
    f32x4 acc[2][2][4][2];
#pragma unroll
    for (int a = 0; a < 2; ++a)
#pragma unroll
        for (int b = 0; b < 2; ++b)
#pragma unroll
            for (int m = 0; m < 4; ++m)
#pragma unroll
                for (int n = 0; n < 2; ++n) acc[a][b][m][n] = (f32x4){0.f, 0.f, 0.f, 0.f};
    bf16x8 At[4][2], B0[2][2], B1[2][2];
    const char* cA = (const char*)g.A + (size_t)cur.pm * tstep; const char* cB = (const char*)g.Bt + (size_t)cur.pn * tstep;
    S.a_ready(cur);
    if constexpr (SP2) {
        PG8_STAGE(PG8_SB(0, 0), cB, voffB); PG8_STAGE(PG8_SB(0, 1), cB + hstep, voffB); PG8_STAGE(PG8_SA(0, 0), cA, voffA); PG8_STAGE(PG8_SA(0, 1), cA + hstep, voffA);
        if (wr == 1) PG8_BAR;
        PG8_WAIT_V(2); PG8_BAR;
        PG8_STAGE(PG8_SB(1, 0), cB + kstep, voffB); PG8_STAGE(PG8_SA(1, 0), cA + kstep, voffA); PG8_STAGE(PG8_SB(1, 1), cB + hstep + kstep, voffB);
        PG8_WAIT_V(6); PG8_BAR;
    } else {
        PG8_STAGE(PG8_SB(0, 0), cB, voffB); PG8_STAGE(PG8_SA(0, 0), cA, voffA); PG8_STAGE(PG8_SB(0, 1), cB + hstep, voffB); PG8_STAGE(PG8_SA(0, 1), cA + hstep, voffA);
        if (wr == 1) PG8_BAR;
        PG8_WAIT_V(4); PG8_BAR;
        PG8_STAGE(PG8_SB(1, 0), cB + kstep, voffB); PG8_STAGE(PG8_SA(1, 0), cA + kstep, voffA); PG8_STAGE(PG8_SB(1, 1), cB + hstep + kstep, voffB);
        PG8_WAIT_V(6); PG8_BAR;
    }
    for (;;) {
        const bool has_next = S.next(ui + 1, nxt);
        const char* nA = has_next ? (const char*)g.A + (size_t)nxt.pm * tstep : cA; const char* nB = has_next ? (const char*)g.Bt + (size_t)nxt.pn * tstep : cB;
        typename Epi::Pre pre; E.prefetch(cur, wr, wc, fr, fq, pre);
        for (int t = 0; t < nt; t += 2) {
            const bool last = (t == nt - 2);
            const char* a1 = cA + (size_t)(t + 1) * kstep;
            const char* a2 = last ? nA : cA + (size_t)(t + 2) * kstep; const char* b2 = last ? nB : cB + (size_t)(t + 2) * kstep;
            const char* a3 = a2 + kstep; const char* b3 = b2 + kstep;
            if (last && has_next) S.a_ready(nxt);
            if constexpr (SP2) {
            PG8_LDB(B0, 0, 0); PG8_LDB(B1, 0, 1); PG8_SCHED; PG8_LDA(At, 0, 0); PG8_STAGE(PG8_SA(1, 1), a1 + hstep, voffA);
            PG8_WAIT_V(8); PG8_WAIT_L(0); PG8_BAR; PG8_MMA(0, 0, At, B0); PG8_MMA(0, 1, At, B1); PG8_BAR; PG8_SCHED;
            PG8_LDA(At, 0, 1); PG8_STAGE(PG8_SB(0, 0), b2, voffB); PG8_STAGE(PG8_SB(0, 1), b2 + hstep, voffB); PG8_STAGE(PG8_SA(0, 0), a2, voffA);
            PG8_WAIT_V(8); PG8_WAIT_L(0); PG8_BAR; PG8_MMA(1, 0, At, B0); PG8_MMA(1, 1, At, B1); PG8_BAR; PG8_SCHED;
            PG8_LDB(B0, 1, 0); PG8_LDB(B1, 1, 1); PG8_SCHED; PG8_LDA(At, 1, 0); PG8_STAGE(PG8_SA(0, 1), a2 + hstep, voffA);
            PG8_WAIT_V(8); PG8_WAIT_L(0); PG8_BAR; PG8_MMA(0, 0, At, B0); PG8_MMA(0, 1, At, B1); PG8_BAR; PG8_SCHED;
            PG8_LDA(At, 1, 1); PG8_STAGE(PG8_SB(1, 0), b3, voffB); PG8_STAGE(PG8_SB(1, 1), b3 + hstep, voffB); PG8_STAGE(PG8_SA(1, 0), a3, voffA);
            PG8_WAIT_V(8); PG8_WAIT_L(0); PG8_BAR; PG8_MMA(1, 0, At, B0); PG8_MMA(1, 1, At, B1); PG8_BAR; PG8_SCHED;
            } else {
            PG8_LDB(B0, 0, 0); PG8_SCHED; PG8_LDA(At, 0, 0); PG8_STAGE(PG8_SA(1, 1), a1 + hstep, voffA);
            PG8_WAIT_L(8); PG8_BAR; PG8_WAIT_L(0); PG8_MMA(0, 0, At, B0); PG8_BAR; PG8_SCHED;
            PG8_LDB(B1, 0, 1); PG8_STAGE(PG8_SB(0, 0), b2, voffB);
            PG8_BAR; PG8_WAIT_L(0); PG8_MMA(0, 1, At, B1); PG8_BAR;
            PG8_LDA(At, 0, 1); PG8_STAGE(PG8_SA(0, 0), a2, voffA);
            PG8_BAR; PG8_WAIT_L(0); PG8_MMA(1, 0, At, B0); PG8_BAR; PG8_SCHED;
            PG8_STAGE(PG8_SB(0, 1), b2 + hstep, voffB);
            PG8_WAIT_V(6); PG8_BAR; PG8_MMA(1, 1, At, B1); PG8_BAR;
            PG8_LDB(B0, 1, 0); PG8_SCHED; PG8_LDA(At, 1, 0); PG8_STAGE(PG8_SA(0, 1), a2 + hstep, voffA);
            PG8_WAIT_L(8); PG8_BAR; PG8_WAIT_L(0); PG8_MMA(0, 0, At, B0); PG8_BAR; PG8_SCHED;
            PG8_LDB(B1, 1, 1); PG8_STAGE(PG8_SB(1, 0), b3, voffB);
            PG8_BAR; PG8_WAIT_L(0); PG8_MMA(0, 1, At, B1); PG8_BAR;
            PG8_LDA(At, 1, 1); PG8_STAGE(PG8_SA(1, 0), a3, voffA);
            PG8_BAR; PG8_WAIT_L(0); PG8_MMA(1, 0, At, B0); PG8_BAR; PG8_SCHED;
            PG8_STAGE(PG8_SB(1, 1), b3 + hstep, voffB);
            PG8_WAIT_V(6); PG8_BAR; PG8_MMA(1, 1, At, B1); PG8_BAR;
            }
        }
        if constexpr (ALIGN_EPI) { if (wr == 0) PG8_BAR; }
        if constexpr (!Epi::AFTER_DRAIN) { E(acc, cur, wr, wc, fr, fq, pre); S.done(cur); }
        if (!has_next) break;
#pragma unroll
        for (int a = 0; a < 2; ++a)
#pragma unroll
            for (int b = 0; b < 2; ++b)
#pragma unroll
                for (int m = 0; m < 4; ++m)
#pragma unroll
                    for (int n = 0; n < 2; ++n) acc[a][b][m][n] = (f32x4){0.f, 0.f, 0.f, 0.f};
        cur = nxt; cA = nA; cB = nB; ++ui;
        if constexpr (ALIGN_EPI) { if (wr == 1) PG8_BAR; }
    }
    PG8_WAIT_V(0);
    if constexpr (!ALIGN_EPI) { if (wr == 0) PG8_BAR; }
    PG8_BAR;
    if constexpr (Epi::AFTER_DRAIN) { E.fused(acc, cur, wr, wc, fr, fq, lds, wid, lane); S.done(cur); }
#undef PG8_SA
#undef PG8_SB
#undef PG8_STAGE
#undef PG8_LDA
#undef PG8_LDB
#undef PG8_MMA
#undef PG8_WAIT_V
#undef PG8_WAIT_L
#undef PG8_BAR
#undef PG8_SCHED
}
}

constexpr int DM = 1024, BATCH = 8, SEQ = 4096, MTOK = BATCH * SEQ, DFF = 2816, S5W = 512, CVW = 512, NIN = 1536;
constexpr int NG = 32, NP = 64, NC = 16, CK = 31;
constexpr float EPS = 1e-6f;
constexpr int NWAVES = 8;
constexpr int LDS_BYTES = 147456;

constexpr size_t MiB = 1u << 20;
constexpr size_t WS_SS = 1 * MiB;
constexpr size_t WS_S5A = 2 * MiB;
constexpr size_t WS_S5AT = WS_S5A + 16384;
constexpr size_t WS_S5BF = WS_S5A + 65536;
constexpr size_t WS_S5CF = WS_S5BF + 262144;
constexpr size_t WS_W1GU = 4 * MiB;
constexpr size_t WS_W1D = 15 * MiB;
constexpr size_t WS_WIN = 21 * MiB;
constexpr size_t WS_WGLU = 24 * MiB;
constexpr size_t WS_WOUT = 25 * MiB;
constexpr size_t WS_W2GU = 27 * MiB;
constexpr size_t WS_W2D = 38 * MiB;
constexpr size_t WS_XB = 48 * MiB;
constexpr size_t WS_A1 = 112 * MiB;
constexpr size_t WS_U = WS_A1 + 0 * MiB;
constexpr size_t WS_Z = WS_A1 + 32 * MiB;
constexpr size_t WS_YS = WS_A1 + 64 * MiB;
constexpr size_t WS_YM = WS_A1 + 96 * MiB;
constexpr size_t WS_END = 448 * MiB;

#define LAS __attribute__((address_space(3)))
typedef unsigned short bf16;
typedef float f32x4 __attribute__((ext_vector_type(4)));
typedef float f32x2 __attribute__((ext_vector_type(2)));
typedef short bf16x8 __attribute__((ext_vector_type(8)));
typedef short bf16x4 __attribute__((ext_vector_type(4)));
typedef unsigned u32x4 __attribute__((ext_vector_type(4)));
typedef unsigned u32x2 __attribute__((ext_vector_type(2)));

__device__ __forceinline__ float bf2f(unsigned short b) { return __uint_as_float(((unsigned)b) << 16); }
__device__ __forceinline__ float fast_sigmoid(float x) { return __builtin_amdgcn_rcpf(1.0f + __expf(-x)); }

template <int CTRL> __device__ __forceinline__ float dpp_mov(float v) {
    return __builtin_bit_cast(float, __builtin_amdgcn_update_dpp(0, __builtin_bit_cast(int, v), CTRL, 0xF, 0xF, true));
}
__device__ __forceinline__ float wave_sum(float v) {
    v += dpp_mov<0xB1>(v);
    v += dpp_mov<0x4E>(v);
    v += dpp_mov<0x141>(v);
    v += dpp_mov<0x140>(v);
    v += __shfl_xor(v, 16);
    v += __shfl_xor(v, 32);
    return v;
}

struct Args { const float* in[27]; float* out; unsigned char* ws; int ph_lo, ph_hi; };

namespace pg8 {
struct EpiSwiGLU {
    static constexpr bool PERM = true, AFTER_DRAIN = false;
    bf16_t* O; int ldc; const float* ss;
    struct Pre { float v[8]; };
    __device__ __forceinline__ void prefetch(const Unit& u, int wr, int wc, int fr, int fq, Pre& p) const {
        const int row0 = u.pm * BM + wr * 64 + fr;
#pragma unroll
        for (int i = 0; i < 8; ++i) p.v[i] = ss[row0 + (i >> 2) * HALF + (i & 3) * 16];
    }
    __device__ __forceinline__ void operator()(const f32x4 (&acc)[2][2][4][2], const Unit& u, int wr, int wc, int fr, int fq, const Pre& pre) const {
        const int row0 = u.pm * BM + wr * 64 + fr, col0 = u.pn * 128 + wc * 32 + 8 * fq;
#pragma unroll
        for (int ai = 0; ai < 2; ++ai)
#pragma unroll
            for (int m = 0; m < 4; ++m) {
                const int row = row0 + ai * HALF + m * 16;
                const float rs = __builtin_amdgcn_rsqf(pre.v[ai * 4 + m] * (1.0f / 1024.0f) + 1e-6f);
                float h[8];
#pragma unroll
                for (int n = 0; n < 2; ++n)
#pragma unroll
                    for (int j = 0; j < 4; ++j) { const float g = acc[ai][0][m][n][j] * rs, up = acc[ai][1][m][n][j] * rs; h[4 * n + j] = g * up * __builtin_amdgcn_rcpf(1.0f + __expf(-g)); }
                u32x4 w; w.x = cvt_pk_bf16(h[0], h[1]); w.y = cvt_pk_bf16(h[2], h[3]); w.z = cvt_pk_bf16(h[4], h[5]); w.w = cvt_pk_bf16(h[6], h[7]);
                *(u32x4*)(O + (size_t)row * ldc + col0) = w;
            }
    }
};
struct EpiResid {
    static constexpr bool PERM = true, AFTER_DRAIN = false;
    bf16_t* XB; float* ss; float scale;
    struct Pre { };
    __device__ __forceinline__ void prefetch(const Unit&, int, int, int, int, Pre&) const {}
    __device__ __forceinline__ void operator()(const f32x4 (&acc)[2][2][4][2], const Unit& u, int wr, int wc, int fr, int fq, const Pre&) const {
        const int row0 = u.pm * BM + wr * 64 + fr, col0 = u.pn * BM + wc * 32 + 8 * fq;
        u32x4 r[2][4][2];
#pragma unroll
        for (int ai = 0; ai < 2; ++ai)
#pragma unroll
            for (int m = 0; m < 4; ++m) { const bf16_t* p = XB + (size_t)(row0 + ai * HALF + m * 16) * 1024 + col0; r[ai][m][0] = *(const u32x4*)p; r[ai][m][1] = *(const u32x4*)(p + HALF); }
#pragma unroll
        for (int ai = 0; ai < 2; ++ai)
#pragma unroll
            for (int m = 0; m < 4; ++m) {
                const int row = row0 + ai * HALF + m * 16; bf16_t* p = XB + (size_t)row * 1024 + col0; float q = 0.f;
#pragma unroll
                for (int bj = 0; bj < 2; ++bj) {
                    const u32x4 rv = r[ai][m][bj]; float v[8];
#pragma unroll
                    for (int e = 0; e < 8; ++e) { const unsigned wd = rv[e >> 1]; const float x = __uint_as_float((e & 1) ? (wd & 0xffff0000u) : (wd << 16));
                        v[e] = fmaf(acc[ai][bj][m][e >> 2][e & 3], scale, x); q = fmaf(v[e], v[e], q); }
                    u32x4 w; w.x = cvt_pk_bf16(v[0], v[1]); w.y = cvt_pk_bf16(v[2], v[3]); w.z = cvt_pk_bf16(v[4], v[5]); w.w = cvt_pk_bf16(v[6], v[7]);
                    *(u32x4*)(p + bj * HALF) = w;
                }
                q += __shfl_xor(q, 16); q += __shfl_xor(q, 32);
                if (fq == 0) atomicAdd(ss + row, q);
            }
    }
};
struct EpiWin {
    static constexpr bool PERM = true, AFTER_DRAIN = false;
    bf16_t* U; bf16_t* Z; const float* ss;
    struct Pre { float v[8]; };
    __device__ __forceinline__ void prefetch(const Unit& u, int wr, int wc, int fr, int fq, Pre& p) const {
        const int row0 = u.pm * BM + wr * 64 + fr;
#pragma unroll
        for (int i = 0; i < 8; ++i) p.v[i] = ss[row0 + (i >> 2) * HALF + (i & 3) * 16];
    }
    __device__ __forceinline__ void operator()(const f32x4 (&acc)[2][2][4][2], const Unit& u, int wr, int wc, int fr, int fq, const Pre& pre) const {
        const int row0 = u.pm * BM + wr * 64 + fr, cw = wc * 32 + 8 * fq;
#pragma unroll
        for (int ai = 0; ai < 2; ++ai)
#pragma unroll
            for (int m = 0; m < 4; ++m) {
                const int row = row0 + ai * HALF + m * 16;
                const float rs = __builtin_amdgcn_rsqf(pre.v[ai * 4 + m] * (1.0f / 1024.0f) + 1e-6f);
                if (u.pn < 2) {
#pragma unroll
                    for (int bj = 0; bj < 2; ++bj) { const f32x4 v0 = acc[ai][bj][m][0] * rs, v1 = acc[ai][bj][m][1] * rs;
                        u32x4 w; w.x = cvt_pk_bf16(v0[0], v0[1]); w.y = cvt_pk_bf16(v0[2], v0[3]); w.z = cvt_pk_bf16(v1[0], v1[1]); w.w = cvt_pk_bf16(v1[2], v1[3]);
                        *(u32x4*)(U + (size_t)row * 512 + u.pn * 256 + bj * HALF + cw) = w; }
                } else {
                    float h[8];
#pragma unroll
                    for (int n = 0; n < 2; ++n)
#pragma unroll
                        for (int j = 0; j < 4; ++j) { const float a = acc[ai][0][m][n][j] * rs, g = acc[ai][1][m][n][j] * rs; h[4 * n + j] = a * __builtin_amdgcn_rcpf(1.0f + __expf(-g)); }
                    u32x4 w; w.x = cvt_pk_bf16(h[0], h[1]); w.y = cvt_pk_bf16(h[2], h[3]); w.z = cvt_pk_bf16(h[4], h[5]); w.w = cvt_pk_bf16(h[6], h[7]);
                    *(u32x4*)(Z + (size_t)row * 512 + (u.pn - 2) * 128 + cw) = w;
                }
            }
    }
};
struct EpiGlu {
    static constexpr bool PERM = true, AFTER_DRAIN = false;
    const bf16_t* YS; bf16_t* YM; const float* bias;
    struct Pre { };
    __device__ __forceinline__ void prefetch(const Unit&, int, int, int, int, Pre&) const {}
    __device__ __forceinline__ void operator()(const f32x4 (&acc)[2][2][4][2], const Unit& u, int wr, int wc, int fr, int fq, const Pre&) const {
        const int row0 = u.pm * BM + wr * 64 + fr, col0 = u.pn * BM + wc * 32 + 8 * fq;
        f32x4 bv[2][2];
#pragma unroll
        for (int bj = 0; bj < 2; ++bj)
#pragma unroll
            for (int n = 0; n < 2; ++n) bv[bj][n] = *(const f32x4*)(bias + col0 + bj * HALF + 4 * n);
        u32x4 yr[2][4][2];
#pragma unroll
        for (int ai = 0; ai < 2; ++ai)
#pragma unroll
            for (int m = 0; m < 4; ++m)
#pragma unroll
                for (int bj = 0; bj < 2; ++bj) yr[ai][m][bj] = *(const u32x4*)(YS + (size_t)(row0 + ai * HALF + m * 16) * 512 + col0 + bj * HALF);
#pragma unroll
        for (int ai = 0; ai < 2; ++ai)
#pragma unroll
            for (int m = 0; m < 4; ++m) {
                const int row = row0 + ai * HALF + m * 16;
#pragma unroll
                for (int bj = 0; bj < 2; ++bj) {
                    const u32x4 yv = yr[ai][m][bj];
                    float h[8];
#pragma unroll
                    for (int n = 0; n < 2; ++n)
#pragma unroll
                        for (int j = 0; j < 4; ++j) { const int e = 4 * n + j; const unsigned wd = yv[e >> 1]; const float y = __uint_as_float((e & 1) ? (wd & 0xffff0000u) : (wd << 16));
                            const float g = acc[ai][bj][m][n][j] + bv[bj][n][j]; h[e] = y * __builtin_amdgcn_rcpf(1.0f + __expf(-g)); }
                    u32x4 w; w.x = cvt_pk_bf16(h[0], h[1]); w.y = cvt_pk_bf16(h[2], h[3]); w.z = cvt_pk_bf16(h[4], h[5]); w.w = cvt_pk_bf16(h[6], h[7]);
                    *(u32x4*)(YM + (size_t)row * 1024 + col0 + bj * HALF) = w;
                }
            }
    }
};
}

__device__ __forceinline__ unsigned f2bf(float f) { unsigned u = __float_as_uint(f); return (u + 0x7fffu + ((u >> 16) & 1u)) >> 16; }
__device__ __forceinline__ unsigned pk2(float lo, float hi) { return f2bf(lo) | (f2bf(hi) << 16); }

__device__ __forceinline__ int rowmap(int mode, int n0) {
    if (mode == 1) return 256 * (n0 >> 7) + (n0 & 127);
    if (mode == 2) return 256 * (n0 >> 7) + 128 + (n0 & 127);
    if (mode == 3) { if (n0 < 512) return n0; if (n0 < 1024) { const int j = n0 - 512; return 512 + 256 * (j >> 7) + (j & 127); } const int j = n0 - 1024; return 512 + 256 * (j >> 7) + 128 + (j & 127); }
    return n0;
}
__device__ __forceinline__ void transpose_item(const float* W, int K, int N, const float* gain, bf16* WT, int mode, LAS float* scr, int item, int lane) {
    const int nblk = N / 32, kb = item / nblk, nb = item % nblk, k0 = 64 * kb, n0 = 32 * nb;
    float wv[32];
#pragma unroll
    for (int i = 0; i < 32; ++i) { const int kk = 2 * i + (lane >> 5); wv[i] = __builtin_nontemporal_load(&W[(size_t)(k0 + kk) * N + n0 + (lane & 31)]); }
    if (gain) {
#pragma unroll
        for (int i = 0; i < 32; ++i) wv[i] *= gain[k0 + 2 * i + (lane >> 5)]; }
#pragma unroll
    for (int i = 0; i < 32; ++i) scr[(2 * i + (lane >> 5)) * 33 + (lane & 31)] = wv[i];
    asm volatile("s_waitcnt lgkmcnt(0)" ::: "memory");
    const int c = lane & 7, d0 = rowmap(mode, n0);
#pragma unroll
    for (int j = 0; j < 4; ++j) { const int n = (lane >> 3) + 8 * j; const LAS float* s = scr + (8 * c) * 33 + n;
        u32x4 o; o.x = pg8::cvt_pk_bf16(s[0 * 33], s[1 * 33]); o.y = pg8::cvt_pk_bf16(s[2 * 33], s[3 * 33]); o.z = pg8::cvt_pk_bf16(s[4 * 33], s[5 * 33]); o.w = pg8::cvt_pk_bf16(s[6 * 33], s[7 * 33]);
        *(u32x4*)(WT + (size_t)(d0 + n) * K + k0 + 8 * c) = o; }
    asm volatile("s_waitcnt lgkmcnt(0)" ::: "memory");
}

__device__ __forceinline__ void my_sincos(float x, float& s, float& c) {
    const float q = rintf(x * 0.636619772367581f);
    float r = fmaf(-q, 1.5703125f, x); r = fmaf(-q, 4.837512969970703e-4f, r); r = fmaf(-q, 7.549789954891882e-8f, r);
    const float z = r * r;
    const float sp = r + r * z * (-1.6666654611e-1f + z * (8.3321608736e-3f + z * (-1.9515295891e-4f)));
    const float cp = 1.0f - 0.5f * z + z * z * (4.166664568298827e-2f + z * (-1.388731625493765e-3f + z * 2.443315711809948e-5f));
    const int qi = ((int)q) & 3;
    s = (qi == 0) ? sp : (qi == 1) ? cp : (qi == 2) ? -sp : -cp;
    c = (qi == 0) ? cp : (qi == 1) ? -sp : (qi == 2) ? -cp : sp;
}
__device__ __forceinline__ void s5_coeffs(const Args& A, int g, int p, float& ar, float& ai, float& fre, float& fim) {
    const float lr = A.in[7][g * NP + p], li = A.in[8][g * NP + p], dt = expf(A.in[9][g]);
    const float mag = expf(lr * dt); float s, c; my_sincos(li * dt, s, c); ar = mag * c; ai = mag * s;
    const float den = lr * lr + li * li, nr = ar - 1.0f, ni = ai;
    fre = (nr * lr + ni * li) / den; fim = (ni * lr - nr * li) / den;
}

__device__ __forceinline__ void prologue(LAS unsigned char* lds, const Args& A, int G) {
    const int tid = threadIdx.x, lane = tid & 63, wave = __builtin_amdgcn_readfirstlane(tid >> 6);
    unsigned char* ws = A.ws;
    LAS float* scr = (LAS float*)(lds + wave * 16384);
    const int gw = blockIdx.x * NWAVES + wave, NGW = G * NWAVES;
    constexpr int I_GU = (DM / 64) * (DFF / 32), I_DN = (DFF / 64) * (DM / 32), I_IN = (DM / 64) * (NIN / 32), I_GL = (S5W / 64) * (S5W / 32), I_OUT = (DM / 64) * (DM / 32);
    constexpr int NITEMS = 4 * I_GU + 2 * I_DN + I_IN + I_GL + I_OUT;
    for (int it = gw; it < NITEMS; it += NGW) {
        int r = it;
        if (r < I_GU) { transpose_item(A.in[2], DM, DFF, A.in[1], (bf16*)(ws + WS_W1GU), 1, scr, r, lane); continue; } r -= I_GU;
        if (r < I_GU) { transpose_item(A.in[3], DM, DFF, A.in[1], (bf16*)(ws + WS_W1GU), 2, scr, r, lane); continue; } r -= I_GU;
        if (r < I_DN) { transpose_item(A.in[4], DFF, DM, nullptr, (bf16*)(ws + WS_W1D), 0, scr, r, lane); continue; } r -= I_DN;
        if (r < I_IN) { transpose_item(A.in[6], DM, NIN, A.in[5], (bf16*)(ws + WS_WIN), 3, scr, r, lane); continue; } r -= I_IN;
        if (r < I_GL) { transpose_item(A.in[15], S5W, S5W, nullptr, (bf16*)(ws + WS_WGLU), 0, scr, r, lane); continue; } r -= I_GL;
        if (r < I_OUT) { transpose_item(A.in[21], DM, DM, nullptr, (bf16*)(ws + WS_WOUT), 0, scr, r, lane); continue; } r -= I_OUT;
        if (r < I_GU) { transpose_item(A.in[23], DM, DFF, A.in[22], (bf16*)(ws + WS_W2GU), 1, scr, r, lane); continue; } r -= I_GU;
        if (r < I_GU) { transpose_item(A.in[24], DM, DFF, A.in[22], (bf16*)(ws + WS_W2GU), 2, scr, r, lane); continue; } r -= I_GU;
        transpose_item(A.in[25], DFF, DM, nullptr, (bf16*)(ws + WS_W2D), 0, scr, r, lane);
    }
    float* ss = (float*)(ws + WS_SS);
    bf16* XB = (bf16*)(ws + WS_XB);
    for (int row = 4 * gw; row < MTOK; row += 4 * NGW) {
        f32x4 v[4][4];
#pragma unroll
        for (int r = 0; r < 4; ++r) { const f32x4* xr = (const f32x4*)(A.in[0] + (size_t)(row + r) * DM) + lane;
#pragma unroll
            for (int j = 0; j < 4; ++j) v[r][j] = __builtin_nontemporal_load(&xr[64 * j]); }
#pragma unroll
        for (int r = 0; r < 4; ++r) { float sq = 0.f;
#pragma unroll
            for (int j = 0; j < 4; ++j) sq += (v[r][j][0] * v[r][j][0] + v[r][j][1] * v[r][j][1]) + (v[r][j][2] * v[r][j][2] + v[r][j][3] * v[r][j][3]);
            sq = wave_sum(sq);
            if (lane == 0) ss[row + r] = sq;
            u32x2* o = (u32x2*)(XB + (size_t)(row + r) * DM) + lane;
#pragma unroll
            for (int j = 0; j < 4; ++j) { u32x2 w; w.x = pg8::cvt_pk_bf16(v[r][j][0], v[r][j][1]); w.y = pg8::cvt_pk_bf16(v[r][j][2], v[r][j][3]); o[64 * j] = w; } }
    }
    const int gt = blockIdx.x * (NWAVES * 64) + tid, NT = G * NWAVES * 64;
    for (int i = gt; i < 3 * MTOK; i += NT) ss[MTOK + i] = 0.f;
    f32x2* abar = (f32x2*)(ws + WS_S5A); f32x2* abarT = (f32x2*)(ws + WS_S5AT);
    u32x4* bfrag = (u32x4*)(ws + WS_S5BF); u32x4* cfrag = (u32x4*)(ws + WS_S5CF);
    for (int i = gt; i < NG * NP; i += NT) {
        const int g = i / NP, p = i % NP; float ar, ai, fre, fim; s5_coeffs(A, g, p, ar, ai, fre, fim);
        abar[i] = (f32x2){ar, ai};
        float tr = ar, ti = ai;
#pragma unroll
        for (int k = 0; k < 5; ++k) { const float nr = tr * tr - ti * ti, ni = 2.0f * tr * ti; tr = nr; ti = ni; }
        abarT[i] = (f32x2){tr, ti};
    }
    for (int i = gt; i < NG * 8 * 64; i += NT) {
        const int ln = i & 63, nt = (i >> 6) & 7, g = i >> 9, p = 16 * (nt & 3) + (ln & 15), c0 = 8 * (ln >> 4);
        u32x4 o = (u32x4){0u, 0u, 0u, 0u};
        if (c0 < 16) {
            float ar, ai, fre, fim; s5_coeffs(A, g, p, ar, ai, fre, fim);
            const float* br = A.in[10] + ((size_t)g * NP + p) * NC + c0; const float* bi = A.in[11] + ((size_t)g * NP + p) * NC + c0;
            float v[8];
#pragma unroll
            for (int k = 0; k < 8; ++k) v[k] = (nt < 4) ? (fre * br[k] - fim * bi[k]) : (fre * bi[k] + fim * br[k]);
            o.x = pk2(v[0], v[1]); o.y = pk2(v[2], v[3]); o.z = pk2(v[4], v[5]); o.w = pk2(v[6], v[7]);
        }
        bfrag[i] = o;
    }
    for (int i = gt; i < NG * 4 * 64; i += NT) {
        const int ln = i & 63, ks = (i >> 6) & 3, g = i >> 8, c = ln & 15, p0 = 16 * ks + 4 * (ln >> 4);
        const float* cr = A.in[12] + ((size_t)g * NC + c) * NP + p0; const float* ci = A.in[13] + ((size_t)g * NC + c) * NP + p0;
        u32x4 o; o.x = pk2(cr[0], -ci[0]); o.y = pk2(cr[1], -ci[1]); o.z = pk2(cr[2], -ci[2]); o.w = pk2(cr[3], -ci[3]);
        cfrag[i] = o;
    }
}

constexpr int XS_PITCH = 68;
constexpr int XS_WAVE_BYTES = 32 * XS_PITCH * 4;
constexpr int CARRY_OFF = NWAVES * XS_WAVE_BYTES;
__device__ __forceinline__ void s5_phase(LAS unsigned char* lds, const Args& A, int G) {
    const int tid = threadIdx.x, lane = tid & 63, w = __builtin_amdgcn_readfirstlane(tid >> 6), fr = lane & 15, fq = lane >> 4;
    unsigned char* ws = A.ws;
    LAS unsigned* xs = (LAS unsigned*)(lds + w * XS_WAVE_BYTES);
    LAS f32x2* carry = (LAS f32x2*)(lds + CARRY_OFF);
    const f32x2* abar = (const f32x2*)(ws + WS_S5A); const f32x2* abarT = (const f32x2*)(ws + WS_S5AT);
    const bf16x8* bfrag = (const bf16x8*)(ws + WS_S5BF); const bf16x8* cfrag = (const bf16x8*)(ws + WS_S5CF);
    const bf16* U = (const bf16*)(ws + WS_U); bf16* YS = (bf16*)(ws + WS_YS);
    for (int item = blockIdx.x; item < BATCH * NG; item += G) {
        const int b = item / NG, g = item % NG;
        const f32x2 a = abar[g * NP + lane], aT = abarT[g * NP + lane];
        bf16x8 bfr[8], cfr[4];
#pragma unroll
        for (int nt = 0; nt < 8; ++nt) bfr[nt] = bfrag[(g * 8 + nt) * 64 + lane];
#pragma unroll
        for (int ks = 0; ks < 4; ++ks) cfr[ks] = cfrag[(g * 4 + ks) * 64 + lane];
        const f32x4 dsk = *(const f32x4*)(A.in[14] + g * NC + 4 * fq);
        const bf16* Ub = U + (size_t)b * SEQ * S5W + g * NC;
        bf16* Yb = YS + (size_t)b * SEQ * S5W + g * NC;
        float xr = 0.f, xi = 0.f;
        bf16x8 uf[2]; u32x2 usk[2];
#pragma unroll
        for (int mt = 0; mt < 2; ++mt) { const size_t t = (size_t)(32 * w + 16 * mt + fr);
            uf[mt] = (bf16x8){0, 0, 0, 0, 0, 0, 0, 0}; if (fq < 2) uf[mt] = *(const bf16x8*)(Ub + t * S5W + 8 * fq);
            usk[mt] = *(const u32x2*)(Ub + t * S5W + 4 * fq); }
        for (int sc = 0; sc < 16; ++sc) {
            const int tb = sc * 256 + 32 * w;
#pragma unroll
            for (int mt = 0; mt < 2; ++mt)
#pragma unroll
                for (int nt = 0; nt < 4; ++nt) {
                    const f32x4 z4 = (f32x4){0.f, 0.f, 0.f, 0.f};
                    const f32x4 dre = __builtin_amdgcn_mfma_f32_16x16x32_bf16(bfr[nt], uf[mt], z4, 0, 0, 0);
                    const f32x4 dim = __builtin_amdgcn_mfma_f32_16x16x32_bf16(bfr[4 + nt], uf[mt], z4, 0, 0, 0);
                    u32x4 wv; wv.x = pg8::cvt_pk_bf16(dre[0], dim[0]); wv.y = pg8::cvt_pk_bf16(dre[1], dim[1]); wv.z = pg8::cvt_pk_bf16(dre[2], dim[2]); wv.w = pg8::cvt_pk_bf16(dre[3], dim[3]);
                    *(LAS u32x4*)(xs + (16 * mt + fr) * XS_PITCH + 16 * nt + 4 * fq) = wv;
                }
            const u32x2 usk_cur0 = usk[0], usk_cur1 = usk[1];
            if (sc + 1 < 16) {
#pragma unroll
                for (int mt = 0; mt < 2; ++mt) { const size_t t = (size_t)(tb + 256 + 16 * mt + fr);
                    if (fq < 2) uf[mt] = *(const bf16x8*)(Ub + t * S5W + 8 * fq);
                    usk[mt] = *(const u32x2*)(Ub + t * S5W + 4 * fq); }
            }
            unsigned v[32];
#pragma unroll
            for (int t = 0; t < 32; ++t) v[t] = xs[t * XS_PITCH + lane];
            float sr = 0.f, si = 0.f;
#pragma unroll
            for (int t = 0; t < 32; ++t) { const float br = __uint_as_float(v[t] << 16), bi = __uint_as_float(v[t] & 0xffff0000u);
                const float nr = fmaf(-a.y, si, fmaf(a.x, sr, br)), ni = fmaf(a.y, sr, fmaf(a.x, si, bi)); sr = nr; si = ni; }
            carry[(sc & 1) * 512 + w * 64 + lane] = (f32x2){sr, si};
            __syncthreads();
            float cr = xr, ci = xi, mr = 0.f, mi = 0.f;
#pragma unroll
            for (int vv = 0; vv < 8; ++vv) { if (vv == w) { mr = cr; mi = ci; }
                const f32x2 e = carry[(sc & 1) * 512 + vv * 64 + lane];
                const float nr = fmaf(-aT.y, ci, fmaf(aT.x, cr, e.x)), ni = fmaf(aT.y, cr, fmaf(aT.x, ci, e.y)); cr = nr; ci = ni; }
            xr = cr; xi = ci;
            sr = mr; si = mi;
#pragma unroll
            for (int t = 0; t < 32; ++t) { const float br = __uint_as_float(v[t] << 16), bi = __uint_as_float(v[t] & 0xffff0000u);
                const float nr = fmaf(-a.y, si, fmaf(a.x, sr, br)), ni = fmaf(a.y, sr, fmaf(a.x, si, bi)); sr = nr; si = ni;
                xs[t * XS_PITCH + lane] = pg8::cvt_pk_bf16(sr, si); }
#pragma unroll
            for (int mt = 0; mt < 2; ++mt) {
                f32x4 d = (f32x4){0.f, 0.f, 0.f, 0.f};
#pragma unroll
                for (int ks = 0; ks < 4; ++ks) { const bf16x8 xf = *(const LAS bf16x8*)(xs + (16 * mt + fr) * XS_PITCH + 16 * ks + 4 * fq);
                    d = __builtin_amdgcn_mfma_f32_16x16x32_bf16(cfr[ks], xf, d, 0, 0, 0); }
                const u32x2 uu = mt ? usk_cur1 : usk_cur0;
                float y[4];
#pragma unroll
                for (int j = 0; j < 4; ++j) { const unsigned wd = uu[j >> 1]; const float uval = __uint_as_float((j & 1) ? (wd & 0xffff0000u) : (wd << 16));
                    const float yy = d[j] + dsk[j] * uval; const float zz = 1.5957691216f * (yy + 0.044715f * yy * yy * yy);
                    y[j] = yy * __builtin_amdgcn_rcpf(1.0f + __expf(-zz)); }
                u32x2 o; o.x = pg8::cvt_pk_bf16(y[0], y[1]); o.y = pg8::cvt_pk_bf16(y[2], y[3]);
                __builtin_nontemporal_store(o, (u32x2*)(Yb + (size_t)(tb + 16 * mt + fr) * S5W + 4 * fq));
            }
        }
    }
    __syncthreads();
}

__device__ __forceinline__ float half_sum(float v) {
    v += dpp_mov<0xB1>(v); v += dpp_mov<0x4E>(v); v += dpp_mov<0x141>(v); v += dpp_mov<0x140>(v);
    v += __shfl_xor(v, 16);
    return v;
}
__device__ __forceinline__ void conv_phase(const Args& A, int G) {
    const int tid = threadIdx.x, lane = tid & 63, wave = __builtin_amdgcn_readfirstlane(tid >> 6);
    unsigned char* ws = A.ws;
    const bf16* Z = (const bf16*)(ws + WS_Z); bf16* YM = (bf16*)(ws + WS_YM);
    const int gw = blockIdx.x * NWAVES + wave, NGW = G * NWAVES;
    constexpr int TT = 16, NTILE = 4, SEGT = TT * NTILE;
    for (int item = gw; item < BATCH * 4 * (SEQ / SEGT); item += NGW) {
        const int seg = item & (SEQ / SEGT - 1), hp = (item >> 6) & 3, b = item >> 8, ch0 = hp * 128 + 2 * lane;
        f32x2 wk[CK];
#pragma unroll
        for (int k = 0; k < CK; ++k) wk[k] = *(const f32x2*)(A.in[17] + k * CVW + ch0);
        const f32x2 bias = *(const f32x2*)(A.in[18] + ch0), lg = *(const f32x2*)(A.in[19] + ch0), lb = *(const f32x2*)(A.in[20] + ch0);
        const bf16* zp = Z + (size_t)b * SEQ * CVW + hp * 128;
        bf16* op = YM + (size_t)b * SEQ * DM + 512 + hp * 128;
        const int t0 = seg * SEGT;
        f32x2 wp[30 + TT];
#pragma unroll
        for (int i = 0; i < 30; ++i) wp[i] = (f32x2){0.f, 0.f};
        if (t0 > 0) {
#pragma unroll
            for (int i = 0; i < 30; ++i) { const unsigned wv = __builtin_nontemporal_load(&((const unsigned*)(zp + (size_t)(t0 - 30 + i) * CVW))[lane]);
                wp[i] = (f32x2){__uint_as_float(wv << 16), __uint_as_float(wv & 0xffff0000u)}; }
        }
#pragma unroll 1
        for (int tt = 0; tt < NTILE; ++tt) {
            const int tb = t0 + TT * tt;
#pragma unroll
            for (int i = 0; i < TT; ++i) { const unsigned wv = __builtin_nontemporal_load(&((const unsigned*)(zp + (size_t)(tb + i) * CVW))[lane]);
                wp[30 + i] = (f32x2){__uint_as_float(wv << 16), __uint_as_float(wv & 0xffff0000u)}; }
#pragma unroll
            for (int i = 0; i < TT; ++i) {
                f32x2 acc = bias;
#pragma unroll
                for (int k = 0; k < CK; ++k) acc = __builtin_elementwise_fma(wk[k], wp[i + k], acc);
                const float s1 = half_sum(acc.x + acc.y), s2 = half_sum(fmaf(acc.x, acc.x, acc.y * acc.y));
                const float mean = s1 * (1.0f / 64.0f);
                const float var = fmaxf(s2 * (1.0f / 64.0f) - mean * mean, 0.0f);
                const float rstd = __builtin_amdgcn_rsqf(var + EPS);
                const f32x2 zn = (acc - mean) * rstd * lg + lb;
                f32x2 y; y.x = zn.x * __builtin_amdgcn_rcpf(1.0f + __expf(-zn.x)); y.y = zn.y * __builtin_amdgcn_rcpf(1.0f + __expf(-zn.y));
                __builtin_nontemporal_store(pg8::cvt_pk_bf16(y.x, y.y), &((unsigned*)(op + (size_t)(tb + i) * DM))[lane]);
            }
#pragma unroll
            for (int i = 0; i < 30; ++i) wp[i] = wp[TT + i];
        }
    }
}

__device__ __forceinline__ void final_phase(const Args& A, int G, int ssi = 3) {
    const int tid = threadIdx.x, lane = tid & 63, wave = __builtin_amdgcn_readfirstlane(tid >> 6);
    const float* ss4 = (const float*)(A.ws + WS_SS) + ssi * MTOK;
    const int gw = blockIdx.x * NWAVES + wave, NGW = G * NWAVES;
    f32x4 gv[4];
#pragma unroll
    for (int j = 0; j < 4; ++j) gv[j] = ((const f32x4*)A.in[26])[64 * j + lane];
    const bf16* XBf = (const bf16*)(A.ws + WS_XB);
    for (int row = 4 * gw; row < MTOK; row += 4 * NGW) {
        u32x2 w[4][4]; float rs[4];
#pragma unroll
        for (int r = 0; r < 4; ++r) { const u32x2* xi = (const u32x2*)(XBf + (size_t)(row + r) * DM) + lane; rs[r] = ss4[row + r];
#pragma unroll
            for (int j = 0; j < 4; ++j) w[r][j] = __builtin_nontemporal_load(&xi[64 * j]); }
#pragma unroll
        for (int r = 0; r < 4; ++r) { const float rr = __builtin_amdgcn_rsqf(rs[r] * (1.0f / 1024.0f) + EPS);
            f32x4* o = (f32x4*)(A.out + (size_t)(row + r) * DM) + lane;
#pragma unroll
            for (int j = 0; j < 4; ++j) { const u32x2 ww = w[r][j];
                const f32x4 v = (f32x4){__uint_as_float(ww.x << 16), __uint_as_float(ww.x & 0xffff0000u), __uint_as_float(ww.y << 16), __uint_as_float(ww.y & 0xffff0000u)};
                __builtin_nontemporal_store(v * rr * gv[j], &o[64 * j]); } }
    }
}


#define GAS __attribute__((address_space(1)))
constexpr size_t WS_CTL = 0, CTL_ZERO_BYTES = 65536;
constexpr int MISC_OFF = 131072 + 320;
#define XB_TMO      128
#define XB_XCNT(j)  (256  + 64 * (j))
#define XB_XSUB(j)  (1280 + 64 * (j))
#define XB_XGEN(j)  (2304 + 64 * (j))
#define XB_TOP      3328
#define XB_TOPGEN   3392
#define XCD_BAR_WORDS 3456
#define XB_SPIN_CAP (1u << 18)

__device__ __forceinline__ unsigned xb_ld(unsigned* p)              { return __hip_atomic_load(p, __ATOMIC_RELAXED, __HIP_MEMORY_SCOPE_AGENT); }
__device__ __forceinline__ unsigned xb_add(unsigned* p, unsigned v) { return __hip_atomic_fetch_add(p, v, __ATOMIC_RELAXED, __HIP_MEMORY_SCOPE_AGENT); }
__device__ __forceinline__ unsigned xb_xcc_id() { return (unsigned)__builtin_amdgcn_s_getreg((3 << 11) | 20) & 0xFu; }
#define XB_SPIN(cond, bar) do { unsigned _sp = 0; while (cond) { __builtin_amdgcn_s_sleep(1); \
    if ((++_sp & 255u) == 0u) { if (xb_ld(&(bar)[XB_TMO])) break; if (_sp > XB_SPIN_CAP) { atomicAdd(&(bar)[XB_TMO], 1u); break; } } } } while (0)

struct XcdBarrier {
    unsigned* bar; unsigned x;
    volatile LAS unsigned* st;
};

__device__ __forceinline__ XcdBarrier xcd_barrier_post(unsigned* bar, volatile LAS unsigned* st) {
    XcdBarrier b; b.bar = bar; b.x = xb_xcc_id(); b.st = st;
    if (threadIdx.x == 0) (void)xb_add(&bar[XB_XCNT(b.x)], 1u);
    return b;
}
__device__ __forceinline__ void xcd_barrier_complete(unsigned* bar, unsigned x, unsigned& nloc, unsigned& nx) {
    const unsigned G = gridDim.x * gridDim.y * gridDim.z;
    unsigned sum, cnt, mine, sp = 0u;
    for (;;) {
        sum = 0u; cnt = 0u; mine = 0u;
#pragma unroll
        for (unsigned j = 0; j < 16; ++j) { const unsigned c = xb_ld(&bar[XB_XCNT(j)]); sum += c; cnt += (c > 0u) ? 1u : 0u; mine = (j == x) ? c : mine; }
        if (sum == G) break;
        __builtin_amdgcn_s_sleep(1);
        if ((++sp & 255u) == 0u) { if (xb_ld(&bar[XB_TMO])) break; if (sp > XB_SPIN_CAP) { atomicAdd(&bar[XB_TMO], 1u); break; } }
    }
    nloc = mine > 0u ? mine : 1u; nx = cnt > 0u ? cnt : 1u;
}

__device__ __forceinline__ void xcd_barrier(const XcdBarrier& b) {
    asm volatile("s_waitcnt vmcnt(0)" ::: "memory");
    __syncthreads();
    if (threadIdx.x == 0) {
        unsigned* bar = b.bar;
        __builtin_amdgcn_s_waitcnt(0);
        unsigned nloc = b.st[0], nx = b.st[1];
        if (nloc == 0u) { xcd_barrier_complete(bar, b.x, nloc, nx); b.st[0] = nloc; b.st[1] = nx; }
        const unsigned old = xb_add(&bar[XB_XSUB(b.x)], 1u);
        const unsigned gen = old / nloc;
        if (old + 1u == (gen + 1u) * nloc) {
            __builtin_amdgcn_fence(__ATOMIC_RELEASE, "agent");
            asm volatile("s_waitcnt vmcnt(0)" ::: "memory");
            const unsigned og = xb_add(&bar[XB_TOP], 1u);
            const unsigned tg = og / nx;
            if (og + 1u == (tg + 1u) * nx) xb_add(&bar[XB_TOPGEN], 1u);
            else XB_SPIN(xb_ld(&bar[XB_TOPGEN]) == tg, bar);
            __builtin_amdgcn_fence(__ATOMIC_ACQUIRE, "agent");
            xb_add(&bar[XB_XGEN(b.x)], 1u);
            asm volatile("s_waitcnt vmcnt(0)" ::: "memory");
        } else {
            XB_SPIN(xb_ld(&bar[XB_XGEN(b.x)]) == gen, bar);
            __builtin_amdgcn_fence(__ATOMIC_ACQUIRE, "agent");
            asm volatile("s_waitcnt vmcnt(0)" ::: "memory");
        }
    }
    __syncthreads();
}

__device__ __forceinline__ void dbg_dump(const Args& A, int G, const bf16* a, int lda, const bf16* b, int ldb) {
    const int gt = blockIdx.x * (NWAVES * 64) + threadIdx.x, NT = G * NWAVES * 64;
    for (size_t i = gt; i < (size_t)MTOK * DM; i += NT) { const size_t row = i >> 10; const int c = (int)(i & 1023);
        A.out[i] = (c < 512) ? bf2f(a[row * lda + c]) : bf2f(b[row * ldb + (c - 512)]); }
}
constexpr int N_PHASES = 10;
__global__ void __launch_bounds__(NWAVES * 64, 2) mk_fwd(Args args) {
    extern __shared__ __attribute__((aligned(16))) unsigned char lds_raw[];
    LAS unsigned char* lds = (LAS unsigned char*)lds_raw;
    const int G = gridDim.x, lo = args.ph_lo, hi = args.ph_hi;
    unsigned char* ws = args.ws;
    float* ss = (float*)(ws + WS_SS);
    bf16* XB = (bf16*)(ws + WS_XB); bf16* A1 = (bf16*)(ws + WS_A1);
#if MK_MULTI
#define GRID_SYNC() do { } while (0)
#else
    volatile LAS unsigned* MISC = (volatile LAS unsigned*)(lds + MISC_OFF);
    if (threadIdx.x < 32) MISC[threadIdx.x] = 0u;
    __syncthreads();
    XcdBarrier bar = xcd_barrier_post((unsigned*)(ws + WS_CTL), MISC + 8);
#define GRID_SYNC() xcd_barrier(bar)
#endif
#define IN(k) (lo <= (k) && (k) < hi)
    if (IN(0)) { prologue(lds, args, G); __syncthreads(); GRID_SYNC(); }
    if (IN(1)) {
        pg8::Gemm g{XB, (const bf16*)(ws + WS_W1GU), MTOK, 2 * DFF, DM}; pg8::StaticOrder S; S.init(MTOK, 2 * DFF, G, (int)blockIdx.x, GU_WGM);
        pg8::EpiSwiGLU E{A1, DFF, ss};
        pg8::gemm_phase<pg8::EpiSwiGLU, pg8::StaticOrder, true, true>(lds, g, S, E);
        GRID_SYNC();
    }
    if (IN(2)) {
        pg8::Gemm g{A1, (const bf16*)(ws + WS_W1D), MTOK, DM, DFF}; pg8::StaticOrder S; S.init(MTOK, DM, G, (int)blockIdx.x, 8, 1);
        pg8::EpiResid E{XB, ss + MTOK, 0.5f};
        pg8::gemm_phase<pg8::EpiResid, pg8::StaticOrder, true, true>(lds, g, S, E);
        GRID_SYNC();
    }
#if DBG_STOP == 2
    if (IN(9)) final_phase(args, G, 1);
    return;
#endif
    if (IN(3)) {
        pg8::Gemm g{XB, (const bf16*)(ws + WS_WIN), MTOK, NIN, DM}; pg8::StaticOrder S; S.init(MTOK, NIN, G, (int)blockIdx.x);
        pg8::EpiWin E{(bf16*)(ws + WS_U), (bf16*)(ws + WS_Z), ss + MTOK};
        pg8::gemm_phase<pg8::EpiWin, pg8::StaticOrder, true, true>(lds, g, S, E);
        GRID_SYNC();
    }
#if DBG_STOP == 3
    if (IN(9)) dbg_dump(args, G, (const bf16*)(ws + WS_U), 512, (const bf16*)(ws + WS_Z), 512);
    return;
#endif
    if (IN(4)) { s5_phase(lds, args, G); conv_phase(args, G); GRID_SYNC(); }
#if DBG_STOP == 4
    if (IN(9)) dbg_dump(args, G, (const bf16*)(ws + WS_YS), 512, (const bf16*)(ws + WS_YM) + 512, 1024);
    return;
#endif
    if (IN(5)) {
        pg8::Gemm g{(const bf16*)(ws + WS_YS), (const bf16*)(ws + WS_WGLU), MTOK, S5W, S5W}; pg8::StaticOrder S; S.init(MTOK, S5W, G, (int)blockIdx.x);
        pg8::EpiGlu E{(const bf16*)(ws + WS_YS), (bf16*)(ws + WS_YM), args.in[16]};
        pg8::gemm_phase<pg8::EpiGlu, pg8::StaticOrder, true, true>(lds, g, S, E);
        GRID_SYNC();
    }
    if (IN(6)) {
        pg8::Gemm g{(const bf16*)(ws + WS_YM), (const bf16*)(ws + WS_WOUT), MTOK, DM, DM}; pg8::StaticOrder S; S.init(MTOK, DM, G, (int)blockIdx.x);
        pg8::EpiResid E{XB, ss + 2 * MTOK, 1.0f};
        pg8::gemm_phase<pg8::EpiResid, pg8::StaticOrder, true, true>(lds, g, S, E);
        GRID_SYNC();
    }
#if DBG_STOP == 6
    if (IN(9)) final_phase(args, G, 2);
    return;
#endif
    if (IN(7)) {
        pg8::Gemm g{XB, (const bf16*)(ws + WS_W2GU), MTOK, 2 * DFF, DM}; pg8::StaticOrder S; S.init(MTOK, 2 * DFF, G, (int)blockIdx.x, GU_WGM);
        pg8::EpiSwiGLU E{A1, DFF, ss + 2 * MTOK};
        pg8::gemm_phase<pg8::EpiSwiGLU, pg8::StaticOrder, true, true>(lds, g, S, E);
        GRID_SYNC();
    }
    if (IN(8)) {
        pg8::Gemm g{A1, (const bf16*)(ws + WS_W2D), MTOK, DM, DFF}; pg8::StaticOrder S; S.init(MTOK, DM, G, (int)blockIdx.x, 8, 1);
        pg8::EpiResid E{XB, ss + 3 * MTOK, 0.5f};
        pg8::gemm_phase<pg8::EpiResid, pg8::StaticOrder, true, true>(lds, g, S, E);
        GRID_SYNC();
    }
    if (IN(9)) final_phase(args, G);
#undef IN
}

extern "C" void kernel_launch(void* const* d_in, const int* in_sizes, int n_in, void* d_out, int out_size, void* d_ws, size_t ws_size, hipStream_t stream) {
    static int grid = 0;
    if (grid == 0) {
        if (n_in != 27 || out_size != MTOK * DM || ws_size < WS_END) { fprintf(stderr, "kernel_launch: unexpected shapes (n_in %d out %d ws %zu)\n", n_in, out_size, ws_size); grid = -1; return; }
        int dev = 0, cus = 0, per_cu = 0;
        hipGetDevice(&dev); hipDeviceGetAttribute(&cus, hipDeviceAttributeMultiprocessorCount, dev);
        if (hipFuncSetAttribute((const void*)mk_fwd, hipFuncAttributeMaxDynamicSharedMemorySize, LDS_BYTES) != hipSuccess) { fprintf(stderr, "kernel_launch: hipFuncSetAttribute failed\n"); grid = -1; return; }
        if (hipOccupancyMaxActiveBlocksPerMultiprocessor(&per_cu, (const void*)mk_fwd, NWAVES * 64, LDS_BYTES) != hipSuccess || per_cu < 1) { fprintf(stderr, "kernel_launch: occupancy query says %d\n", per_cu); per_cu = 1; }
        (void)hipGetLastError();
        grid = cus;
    }
    if (grid < 0) return;
    Args a{};
    for (int i = 0; i < 27; ++i) a.in[i] = (const float*)d_in[i];
    a.out = (float*)d_out; a.ws = (unsigned char*)d_ws;
#if MK_MULTI
    for (int p = 0; p < N_PHASES; ++p) { a.ph_lo = p; a.ph_hi = p + 1; hipLaunchKernelGGL(mk_fwd, dim3(grid), dim3(NWAVES * 64), LDS_BYTES, stream, a); }
#else
    a.ph_lo = 0; a.ph_hi = N_PHASES;
    if (hipMemsetAsync((char*)d_ws + WS_CTL, 0, CTL_ZERO_BYTES, stream) != hipSuccess) { fprintf(stderr, "kernel_launch: hipMemsetAsync failed\n"); return; }
    void* kargs[] = {&a};
    hipError_t e = hipLaunchCooperativeKernel((const void*)mk_fwd, dim3(grid), dim3(NWAVES * 64), kargs, LDS_BYTES, stream);
    if (e != hipSuccess) fprintf(stderr, "kernel_launch: cooperative launch failed: %s (grid %d)\n", hipGetErrorString(e), grid);
#endif
}
```

```cpp
#include <hip/hip_runtime.h>
#include <hip/hip_cooperative_groups.h>
#include <cstdio>
#include <cstdint>
namespace cg = cooperative_groups;

#ifndef GU_WGM
#define GU_WGM 4
#endif
#ifndef DBG_STOP
#define DBG_STOP 0
#endif
#ifndef MK_MULTI
#define MK_MULTI 0
#endif

namespace pg8 {
#define PG8_LAS __attribute__((address_space(3)))
typedef unsigned short bf16_t;
typedef short bf16x8 __attribute__((ext_vector_type(8)));
typedef float f32x4 __attribute__((ext_vector_type(4)));
typedef unsigned u32x4 __attribute__((ext_vector_type(4)));
constexpr int BM = 256, BK = 64, HALF = 128, HTB = HALF * BK * 2  , STAGE_BYTES = 8 * HTB, NXCD = 8, WGM = 8;

__host__ __device__ __forceinline__ int lds_byte(int r, int c) { const int st = (r >> 4) * 2 + (c >> 5), rr = r & 15, cc = c & 31, ob = rr * 64 + cc * 2; return st * 1024 + (ob ^ (((ob >> 9) & 1) << 5)); }
__host__ __device__ __forceinline__ void stage_rc(int b, int& R, int& C) { const int st = b / 1024, sb = b % 1024, swz = sb ^ (((sb >> 9) & 1) << 5); R = (st >> 1) * 16 + swz / 64; C = (st & 1) * 32 + (swz % 64) / 2; }
__host__ __device__ __forceinline__ int perm32(int rho) { const int n = rho >> 4, i = rho & 15; return 8 * (i >> 2) + 4 * n + (i & 3); }

struct Unit { int pm, pn; };
struct Gemm { const bf16_t* A; const bf16_t* Bt; int M, N, K; };

struct StaticOrder {
    int nM, nN, nwg, G, c, wgm, rev;
    __host__ __device__ void init(int M, int N, int G_, int c_, int wgm_ = WGM, int rev_ = 0) { nM = M / BM; nN = N / BM; nwg = nM * nN; G = G_; c = c_; wgm = wgm_; rev = rev_; }
    __host__ __device__ bool next(int i, Unit& u) const {
        const int nr = nwg / G; const bool rv = rev && (nwg % G == 0);
        const long L = (long)((rv && i < nr) ? nr - 1 - i : i) * G + c; if (L >= nwg) return false;
        int wgid = (int)L; { const int q = nwg / NXCD, r = nwg % NXCD, xcd = wgid % NXCD, off = wgid / NXCD; wgid = (xcd < r ? xcd * (q + 1) : r * (q + 1) + (xcd - r) * q) + off; }
        const int nig = wgm * nN, gid = wgid / nig, fm = gid * wgm, gsz = (nM - fm) < wgm ? (nM - fm) : wgm;
        u.pm = fm + ((wgid % nig) % gsz); u.pn = (wgid % nig) / gsz; return true;
    }
    __device__ __forceinline__ void a_ready(const Unit&) const {}
    __device__ __forceinline__ void done(const Unit&) const {}
};

typedef __bf16 bf16v2_t __attribute__((ext_vector_type(2)));
typedef float f32v2_t __attribute__((ext_vector_type(2)));
__device__ __forceinline__ unsigned cvt_pk_bf16(float lo, float hi) { const f32v2_t f = {lo, hi}; const bf16v2_t r = __builtin_convertvector(f, bf16v2_t); return __builtin_bit_cast(unsigned, r); }
typedef float f32x2 __attribute__((ext_vector_type(2)));
typedef unsigned u32x2 __attribute__((ext_vector_type(2)));
template <class Epi, class Sched, bool ALIGN_EPI = false, bool SP2 = false>
__device__ __forceinline__ void gemm_phase(PG8_LAS unsigned char* lds, const Gemm g, const Sched& S, const Epi& E) {
    const int tid = threadIdx.x, wid = __builtin_amdgcn_readfirstlane(tid >> 6), lane = tid & 63, wr = wid >> 2, wc = wid & 3, fr = lane & 15, fq = lane >> 4;
    const int K = g.K, nt = K / BK;
    unsigned voffA[2], voffB[2];
#pragma unroll
    for (int i = 0; i < 2; ++i) { int R, C; stage_rc(tid * 16 + i * 8192, R, C); const int Rb = Epi::PERM ? ((R & ~31) + perm32(R & 31)) : R;
        voffA[i] = (unsigned)(R * K + C) * 2u; voffB[i] = (unsigned)(Rb * K + C) * 2u; }
    const size_t kstep = (size_t)(BK * 2);
    const size_t hstep = (size_t)HALF * K * 2;
    const size_t tstep = 2 * hstep;
    const unsigned ldsw = (unsigned)wid * 1024u;
    const int aoff = lds_byte(wr * 64 + fr, fq * 8), boff = lds_byte(wc * 32 + fr, fq * 8);
#define PG8_SA(b, h) (((b) * 2 + (h)) * HTB)
#define PG8_SB(b, h) ((4 + (b) * 2 + (h)) * HTB)
#define PG8_STAGE(bufoff, gbase, voff) do { _Pragma("unroll") for (int _i = 0; _i < 2; ++_i) \
        __builtin_amdgcn_global_load_lds((const unsigned*)((const char*)(gbase) + (voff)[_i]), (PG8_LAS unsigned*)(lds + (bufoff) + ldsw + _i * 8192), 16, 0, 0); } while (0)
#define PG8_LDA(dst, b, h) do { _Pragma("unroll") for (int m = 0; m < 4; ++m) _Pragma("unroll") for (int k = 0; k < 2; ++k) dst[m][k] = *(const PG8_LAS bf16x8*)(lds + PG8_SA(b, h) + aoff + m * 2048 + k * 1024); } while (0)
#define PG8_LDB(dst, b, h) do { _Pragma("unroll") for (int n = 0; n < 2; ++n) _Pragma("unroll") for (int k = 0; k < 2; ++k) dst[n][k] = *(const PG8_LAS bf16x8*)(lds + PG8_SB(b, h) + boff + n * 2048 + k * 1024); } while (0)
#define PG8_MMA(ai, bj, At, Bt) do { __builtin_amdgcn_s_setprio(1); _Pragma("unroll") for (int m = 0; m < 4; ++m) _Pragma("unroll") for (int n = 0; n < 2; ++n) _Pragma("unroll") for (int k = 0; k < 2; ++k) \
        acc[ai][bj][m][n] = __builtin_amdgcn_mfma_f32_16x16x32_bf16(Bt[n][k], At[m][k], acc[ai][bj][m][n], 0, 0, 0); __builtin_amdgcn_s_setprio(0); } while (0)
#define PG8_WAIT_V(n) asm volatile("s_waitcnt vmcnt(" #n ")" ::: "memory")
#define PG8_WAIT_L(n) asm volatile("s_waitcnt lgkmcnt(" #n ")" ::: "memory")
#define PG8_BAR __builtin_amdgcn_s_barrier()
#define PG8_SCHED __builtin_amdgcn_sched_barrier(0)
    Unit cur, nxt; int ui = 0;
    if (!S.next(0, cur)) return;
    f32x4 acc[2][2][4][2];
#pragma unroll
    for (int a = 0; a < 2; ++a)
#pragma unroll
        for (int b = 0; b < 2; ++b)
#pragma unroll
            for (int m = 0; m < 4; ++m)
#pragma unroll
                for (int n = 0; n < 2; ++n) acc[a][b][m][n] = (f32x4){0.f, 0.f, 0.f, 0.f};
    bf16x8 At[4][2], B0[2][2], B1[2][2];
    const char* cA = (const char*)g.A + (size_t)cur.pm * tstep; const char* cB = (const char*)g.Bt + (size_t)cur.pn * tstep;
    S.a_ready(cur);
    if constexpr (SP2) {
        PG8_STAGE(PG8_SB(0, 0), cB, voffB); PG8_STAGE(PG8_SB(0, 1), cB + hstep, voffB); PG8_STAGE(PG8_SA(0, 0), cA, voffA); PG8_STAGE(PG8_SA(0, 1), cA + hstep, voffA);
        if (wr == 1) PG8_BAR;
        PG8_WAIT_V(2); PG8_BAR;
        PG8_STAGE(PG8_SB(1, 0), cB + kstep, voffB); PG8_STAGE(PG8_SA(1, 0), cA + kstep, voffA); PG8_STAGE(PG8_SB(1, 1), cB + hstep + kstep, voffB);
        PG8_WAIT_V(6); PG8_BAR;
    } else {
        PG8_STAGE(PG8_SB(0, 0), cB, voffB); PG8_STAGE(PG8_SA(0, 0), cA, voffA); PG8_STAGE(PG8_SB(0, 1), cB + hstep, voffB); PG8_STAGE(PG8_SA(0, 1), cA + hstep, voffA);
        if (wr == 1) PG8_BAR;
        PG8_WAIT_V(4); PG8_BAR;
        PG8_STAGE(PG8_SB(1, 0), cB + kstep, voffB); PG8_STAGE(PG8_SA(1, 0), cA + kstep, voffA); PG8_STAGE(PG8_SB(1, 1), cB + hstep + kstep, voffB);
        PG8_WAIT_V(6); PG8_BAR;
    }
    for (;;) {
        const bool has_next = S.next(ui + 1, nxt);
        const char* nA = has_next ? (const char*)g.A + (size_t)nxt.pm * tstep : cA; const char* nB = has_next ? (const char*)g.Bt + (size_t)nxt.pn * tstep : cB;
        typename Epi::Pre pre; E.prefetch(cur, wr, wc, fr, fq, pre);
        for (int t = 0; t < nt; t += 2) {
            const bool last = (t == nt - 2);
            const char* a1 = cA + (size_t)(t + 1) * kstep;
            const char* a2 = last ? nA : cA + (size_t)(t + 2) * kstep; const char* b2 = last ? nB : cB + (size_t)(t + 2) * kstep;
            const char* a3 = a2 + kstep; const char* b3 = b2 + kstep;
            if (last && has_next) S.a_ready(nxt);
            if constexpr (SP2) {
            PG8_LDB(B0, 0, 0); PG8_LDB(B1, 0, 1); PG8_SCHED; PG8_LDA(At, 0, 0); PG8_STAGE(PG8_SA(1, 1), a1 + hstep, voffA);
            PG8_WAIT_V(8); PG8_WAIT_L(0); PG8_BAR; PG8_MMA(0, 0, At, B0); PG8_MMA(0, 1, At, B1); PG8_BAR; PG8_SCHED;
            PG8_LDA(At, 0, 1); PG8_STAGE(PG8_SB(0, 0), b2, voffB); PG8_STAGE(PG8_SB(0, 1), b2 + hstep, voffB); PG8_STAGE(PG8_SA(0, 0), a2, voffA);
            PG8_WAIT_V(8); PG8_WAIT_L(0); PG8_BAR; PG8_MMA(1, 0, At, B0); PG8_MMA(1, 1, At, B1); PG8_BAR; PG8_SCHED;
            PG8_LDB(B0, 1, 0); PG8_LDB(B1, 1, 1); PG8_SCHED; PG8_LDA(At, 1, 0); PG8_STAGE(PG8_SA(0, 1), a2 + hstep, voffA);
            PG8_WAIT_V(8); PG8_WAIT_L(0); PG8_BAR; PG8_MMA(0, 0, At, B0); PG8_MMA(0, 1, At, B1); PG8_BAR; PG8_SCHED;
            PG8_LDA(At, 1, 1); PG8_STAGE(PG8_SB(1, 0), b3, voffB); PG8_STAGE(PG8_SB(1, 1), b3 + hstep, voffB); PG8_STAGE(PG8_SA(1, 0), a3, voffA);
            PG8_WAIT_V(8); PG8_WAIT_L(0); PG8_BAR; PG8_MMA(1, 0, At, B0); PG8_MMA(1, 1, At, B1); PG8_BAR; PG8_SCHED;
            } else {
            PG8_LDB(B0, 0, 0); PG8_SCHED; PG8_LDA(At, 0, 0); PG8_STAGE(PG8_SA(1, 1), a1 + hstep, voffA);
            PG8_WAIT_L(8); PG8_BAR; PG8_WAIT_L(0); PG8_MMA(0, 0, At, B0); PG8_BAR; PG8_SCHED;
            PG8_LDB(B1, 0, 1); PG8_STAGE(PG8_SB(0, 0), b2, voffB);
            PG8_BAR; PG8_WAIT_L(0); PG8_MMA(0, 1, At, B1); PG8_BAR;
            PG8_LDA(At, 0, 1); PG8_STAGE(PG8_SA(0, 0), a2, voffA);
            PG8_BAR; PG8_WAIT_L(0); PG8_MMA(1, 0, At, B0); PG8_BAR; PG8_SCHED;
            PG8_STAGE(PG8_SB(0, 1), b2 + hstep, voffB);
            PG8_WAIT_V(6); PG8_BAR; PG8_MMA(1, 1, At, B1); PG8_BAR;
            PG8_LDB(B0, 1, 0); PG8_SCHED; PG8_LDA(At, 1, 0); PG8_STAGE(PG8_SA(0, 1), a2 + hstep, voffA);
            PG8_WAIT_L(8); PG8_BAR; PG8_WAIT_L(0); PG8_MMA(0, 0, At, B0); PG8_BAR; PG8_SCHED;
            PG8_LDB(B1, 1, 1); PG8_STAGE(PG8_SB(1, 0), b3, voffB);
            PG8_BAR; PG8_WAIT_L(0); PG8_MMA(0, 1, At, B1); PG8_BAR;
            PG8_LDA(At, 1, 1); PG8_STAGE(PG8_SA(1, 0), a3, voffA);
            PG8_BAR; PG8_WAIT_L(0); PG8_MMA(1, 0, At, B0); PG8_BAR; PG8_SCHED;
            PG8_STAGE(PG8_SB(1, 1), b3 + hstep, voffB);
            PG8_WAIT_V(6); PG8_BAR; PG8_MMA(1, 1, At, B1); PG8_BAR;
            }
        }
        if constexpr (ALIGN_EPI) { if (wr == 0) PG8_BAR; }
        if constexpr (!Epi::AFTER_DRAIN) { E(acc, cur, wr, wc, fr, fq, pre); S.done(cur); }
        if (!has_next) break;
#pragma unroll
        for (int a = 0; a < 2; ++a)
#pragma unroll
            for (int b = 0; b < 2; ++b)
#pragma unroll
                for (int m = 0; m < 4; ++m)
#pragma unroll
                    for (int n = 0; n < 2; ++n) acc[a][b][m][n] = (f32x4){0.f, 0.f, 0.f, 0.f};
        cur = nxt; cA = nA; cB = nB; ++ui;
        if constexpr (ALIGN_EPI) { if (wr == 1) PG8_BAR; }
    }
    PG8_WAIT_V(0);
    if constexpr (!ALIGN_EPI) { if (wr == 0) PG8_BAR; }
    PG8_BAR;
    if constexpr (Epi::AFTER_DRAIN) { E.fused(acc, cur, wr, wc, fr, fq, lds, wid, lane); S.done(cur); }
#undef PG8_SA
#undef PG8_SB
#undef PG8_STAGE
#undef PG8_LDA
#undef PG8_LDB
#undef PG8_MMA
#undef PG8_WAIT_V
#undef PG8_WAIT_L
#undef PG8_BAR
#undef PG8_SCHED
}
}

constexpr int DM = 1024, BATCH = 8, SEQ = 4096, MTOK = BATCH * SEQ, DFF = 2816, S5W = 512, CVW = 512, NIN = 1536;
constexpr int NG = 32, NP = 64, NC = 16, CK = 31;
constexpr float EPS = 1e-6f;
constexpr int NWAVES = 8;
constexpr int LDS_BYTES = 147456;

constexpr size_t MiB = 1u << 20;
constexpr size_t WS_SS = 1 * MiB;
constexpr size_t WS_S5A = 2 * MiB;
constexpr size_t WS_S5AT = WS_S5A + 16384;
constexpr size_t WS_S5BF = WS_S5A + 65536;
constexpr size_t WS_S5CF = WS_S5BF + 262144;
constexpr size_t WS_W1GU = 4 * MiB;
constexpr size_t WS_W1D = 15 * MiB;
constexpr size_t WS_WIN = 21 * MiB;
constexpr size_t WS_WGLU = 24 * MiB;
constexpr size_t WS_WOUT = 25 * MiB;
constexpr size_t WS_W2GU = 27 * MiB;
constexpr size_t WS_W2D = 38 * MiB;
constexpr size_t WS_XB = 48 * MiB;
constexpr size_t WS_A1 = 112 * MiB;
constexpr size_t WS_U = WS_A1 + 0 * MiB;
constexpr size_t WS_Z = WS_A1 + 32 * MiB;
constexpr size_t WS_YS = WS_A1 + 64 * MiB;
constexpr size_t WS_YM = WS_A1 + 96 * MiB;
constexpr size_t WS_END = 448 * MiB;

#define LAS __attribute__((address_space(3)))
typedef unsigned short bf16;
typedef float f32x4 __attribute__((ext_vector_type(4)));
typedef float f32x2 __attribute__((ext_vector_type(2)));
typedef short bf16x8 __attribute__((ext_vector_type(8)));
typedef short bf16x4 __attribute__((ext_vector_type(4)));
typedef unsigned u32x4 __attribute__((ext_vector_type(4)));
typedef unsigned u32x2 __attribute__((ext_vector_type(2)));

__device__ __forceinline__ float bf2f(unsigned short b) { return __uint_as_float(((unsigned)b) << 16); }
__device__ __forceinline__ float fast_sigmoid(float x) { return __builtin_amdgcn_rcpf(1.0f + __expf(-x)); }

template <int CTRL> __device__ __forceinline__ float dpp_mov(float v) {
    return __builtin_bit_cast(float, __builtin_amdgcn_update_dpp(0, __builtin_bit_cast(int, v), CTRL, 0xF, 0xF, true));
}
__device__ __forceinline__ float wave_sum(float v) {
    v += dpp_mov<0xB1>(v);
    v += dpp_mov<0x4E>(v);
    v += dpp_mov<0x141>(v);
    v += dpp_mov<0x140>(v);
    v += __shfl_xor(v, 16);
    v += __shfl_xor(v, 32);
    return v;
}

struct Args { const float* in[27]; float* out; unsigned char* ws; int ph_lo, ph_hi; };

namespace pg8 {
struct EpiSwiGLU {
    static constexpr bool PERM = true, AFTER_DRAIN = false;
    bf16_t* O; int ldc; const float* ss;
    struct Pre { float v[8]; };
    __device__ __forceinline__ void prefetch(const Unit& u, int wr, int wc, int fr, int fq, Pre& p) const {
        const int row0 = u.pm * BM + wr * 64 + fr;
#pragma unroll
        for (int i = 0; i < 8; ++i) p.v[i] = ss[row0 + (i >> 2) * HALF + (i & 3) * 16];
    }
    __device__ __forceinline__ void operator()(const f32x4 (&acc)[2][2][4][2], const Unit& u, int wr, int wc, int fr, int fq, const Pre& pre) const {
        const int row0 = u.pm * BM + wr * 64 + fr, col0 = u.pn * 128 + wc * 32 + 8 * fq;
#pragma unroll
        for (int ai = 0; ai < 2; ++ai)
#pragma unroll
            for (int m = 0; m < 4; ++m) {
                const int row = row0 + ai * HALF + m * 16;
                const float rs = __builtin_amdgcn_rsqf(pre.v[ai * 4 + m] * (1.0f / 1024.0f) + 1e-6f);
                float h[8];
#pragma unroll
                for (int n = 0; n < 2; ++n)
#pragma unroll
                    for (int j = 0; j < 4; ++j) { const float g = acc[ai][0][m][n][j] * rs, up = acc[ai][1][m][n][j] * rs; h[4 * n + j] = g * up * __builtin_amdgcn_rcpf(1.0f + __expf(-g)); }
                u32x4 w; w.x = cvt_pk_bf16(h[0], h[1]); w.y = cvt_pk_bf16(h[2], h[3]); w.z = cvt_pk_bf16(h[4], h[5]); w.w = cvt_pk_bf16(h[6], h[7]);
                *(u32x4*)(O + (size_t)row * ldc + col0) = w;
            }
    }
};
struct EpiResid {
    static constexpr bool PERM = true, AFTER_DRAIN = false;
    bf16_t* XB; float* ss; float scale;
    struct Pre { };
    __device__ __forceinline__ void prefetch(const Unit&, int, int, int, int, Pre&) const {}
    __device__ __forceinline__ void operator()(const f32x4 (&acc)[2][2][4][2], const Unit& u, int wr, int wc, int fr, int fq, const Pre&) const {
        const int row0 = u.pm * BM + wr * 64 + fr, col0 = u.pn * BM + wc * 32 + 8 * fq;
#pragma unroll
        for (int ai = 0; ai < 2; ++ai)
#pragma unroll
            for (int m = 0; m < 4; ++m) {
                const int row = row0 + ai * HALF + m * 16; bf16_t* p = XB + (size_t)row * 1024 + col0; float q = 0.f;
                const u32x4 r0 = *(const u32x4*)p, r1 = *(const u32x4*)(p + HALF);
#pragma unroll
                for (int bj = 0; bj < 2; ++bj) {
                    const u32x4 rv = bj ? r1 : r0; float v[8];
#pragma unroll
                    for (int e = 0; e < 8; ++e) { const unsigned wd = rv[e >> 1]; const float x = __uint_as_float((e & 1) ? (wd & 0xffff0000u) : (wd << 16));
                        v[e] = fmaf(acc[ai][bj][m][e >> 2][e & 3], scale, x); q = fmaf(v[e], v[e], q); }
                    u32x4 w; w.x = cvt_pk_bf16(v[0], v[1]); w.y = cvt_pk_bf16(v[2], v[3]); w.z = cvt_pk_bf16(v[4], v[5]); w.w = cvt_pk_bf16(v[6], v[7]);
                    *(u32x4*)(p + bj * HALF) = w;
                }
                q += __shfl_xor(q, 16); q += __shfl_xor(q, 32);
                if (fq == 0) atomicAdd(ss + row, q);
            }
    }
};
struct EpiWin {
    static constexpr bool PERM = true, AFTER_DRAIN = false;
    bf16_t* U; bf16_t* Z; const float* ss;
    struct Pre { float v[8]; };
    __device__ __forceinline__ void prefetch(const Unit& u, int wr, int wc, int fr, int fq, Pre& p) const {
        const int row0 = u.pm * BM + wr * 64 + fr;
#pragma unroll
        for (int i = 0; i < 8; ++i) p.v[i] = ss[row0 + (i >> 2) * HALF + (i & 3) * 16];
    }
    __device__ __forceinline__ void operator()(const f32x4 (&acc)[2][2][4][2], const Unit& u, int wr, int wc, int fr, int fq, const Pre& pre) const {
        const int row0 = u.pm * BM + wr * 64 + fr, cw = wc * 32 + 8 * fq;
#pragma unroll
        for (int ai = 0; ai < 2; ++ai)
#pragma unroll
            for (int m = 0; m < 4; ++m) {
                const int row = row0 + ai * HALF + m * 16;
                const float rs = __builtin_amdgcn_rsqf(pre.v[ai * 4 + m] * (1.0f / 1024.0f) + 1e-6f);
                if (u.pn < 2) {
#pragma unroll
                    for (int bj = 0; bj < 2; ++bj) { const f32x4 v0 = acc[ai][bj][m][0] * rs, v1 = acc[ai][bj][m][1] * rs;
                        u32x4 w; w.x = cvt_pk_bf16(v0[0], v0[1]); w.y = cvt_pk_bf16(v0[2], v0[3]); w.z = cvt_pk_bf16(v1[0], v1[1]); w.w = cvt_pk_bf16(v1[2], v1[3]);
                        *(u32x4*)(U + (size_t)row * 512 + u.pn * 256 + bj * HALF + cw) = w; }
                } else {
                    float h[8];
#pragma unroll
                    for (int n = 0; n < 2; ++n)
#pragma unroll
                        for (int j = 0; j < 4; ++j) { const float a = acc[ai][0][m][n][j] * rs, g = acc[ai][1][m][n][j] * rs; h[4 * n + j] = a * __builtin_amdgcn_rcpf(1.0f + __expf(-g)); }
                    u32x4 w; w.x = cvt_pk_bf16(h[0], h[1]); w.y = cvt_pk_bf16(h[2], h[3]); w.z = cvt_pk_bf16(h[4], h[5]); w.w = cvt_pk_bf16(h[6], h[7]);
                    *(u32x4*)(Z + (size_t)row * 512 + (u.pn - 2) * 128 + cw) = w;
                }
            }
    }
};
struct EpiGlu {
    static constexpr bool PERM = true, AFTER_DRAIN = false;
    const bf16_t* YS; bf16_t* YM; const float* bias;
    struct Pre { };
    __device__ __forceinline__ void prefetch(const Unit&, int, int, int, int, Pre&) const {}
    __device__ __forceinline__ void operator()(const f32x4 (&acc)[2][2][4][2], const Unit& u, int wr, int wc, int fr, int fq, const Pre&) const {
        const int row0 = u.pm * BM + wr * 64 + fr, col0 = u.pn * BM + wc * 32 + 8 * fq;
        f32x4 bv[2][2];
#pragma unroll
        for (int bj = 0; bj < 2; ++bj)
#pragma unroll
            for (int n = 0; n < 2; ++n) bv[bj][n] = *(const f32x4*)(bias + col0 + bj * HALF + 4 * n);
#pragma unroll
        for (int ai = 0; ai < 2; ++ai)
#pragma unroll
            for (int m = 0; m < 4; ++m) {
                const int row = row0 + ai * HALF + m * 16;
#pragma unroll
                for (int bj = 0; bj < 2; ++bj) {
                    const u32x4 yv = *(const u32x4*)(YS + (size_t)row * 512 + col0 + bj * HALF);
                    float h[8];
#pragma unroll
                    for (int n = 0; n < 2; ++n)
#pragma unroll
                        for (int j = 0; j < 4; ++j) { const int e = 4 * n + j; const unsigned wd = yv[e >> 1]; const float y = __uint_as_float((e & 1) ? (wd & 0xffff0000u) : (wd << 16));
                            const float g = acc[ai][bj][m][n][j] + bv[bj][n][j]; h[e] = y * __builtin_amdgcn_rcpf(1.0f + __expf(-g)); }
                    u32x4 w; w.x = cvt_pk_bf16(h[0], h[1]); w.y = cvt_pk_bf16(h[2], h[3]); w.z = cvt_pk_bf16(h[4], h[5]); w.w = cvt_pk_bf16(h[6], h[7]);
                    *(u32x4*)(YM + (size_t)row * 1024 + col0 + bj * HALF) = w;
                }
            }
    }
};
}

__device__ __forceinline__ unsigned f2bf(float f) { unsigned u = __float_as_uint(f); return (u + 0x7fffu + ((u >> 16) & 1u)) >> 16; }
__device__ __forceinline__ unsigned pk2(float lo, float hi) { return f2bf(lo) | (f2bf(hi) << 16); }

__device__ __forceinline__ int rowmap(int mode, int n0) {
    if (mode == 1) return 256 * (n0 >> 7) + (n0 & 127);
    if (mode == 2) return 256 * (n0 >> 7) + 128 + (n0 & 127);
    if (mode == 3) { if (n0 < 512) return n0; if (n0 < 1024) { const int j = n0 - 512; return 512 + 256 * (j >> 7) + (j & 127); } const int j = n0 - 1024; return 512 + 256 * (j >> 7) + 128 + (j & 127); }
    return n0;
}
__device__ __forceinline__ void transpose_item(const float* W, int K, int N, const float* gain, bf16* WT, int mode, LAS float* scr, int item, int lane) {
    const int nblk = N / 32, kb = item / nblk, nb = item % nblk, k0 = 64 * kb, n0 = 32 * nb;
    float wv[32];
#pragma unroll
    for (int i = 0; i < 32; ++i) { const int kk = 2 * i + (lane >> 5); wv[i] = __builtin_nontemporal_load(&W[(size_t)(k0 + kk) * N + n0 + (lane & 31)]); }
    if (gain) {
#pragma unroll
        for (int i = 0; i < 32; ++i) wv[i] *= gain[k0 + 2 * i + (lane >> 5)]; }
#pragma unroll
    for (int i = 0; i < 32; ++i) scr[(2 * i + (lane >> 5)) * 33 + (lane & 31)] = wv[i];
    asm volatile("s_waitcnt lgkmcnt(0)" ::: "memory");
    const int c = lane & 7, d0 = rowmap(mode, n0);
#pragma unroll
    for (int j = 0; j < 4; ++j) { const int n = (lane >> 3) + 8 * j; const LAS float* s = scr + (8 * c) * 33 + n;
        u32x4 o; o.x = pg8::cvt_pk_bf16(s[0 * 33], s[1 * 33]); o.y = pg8::cvt_pk_bf16(s[2 * 33], s[3 * 33]); o.z = pg8::cvt_pk_bf16(s[4 * 33], s[5 * 33]); o.w = pg8::cvt_pk_bf16(s[6 * 33], s[7 * 33]);
        *(u32x4*)(WT + (size_t)(d0 + n) * K + k0 + 8 * c) = o; }
    asm volatile("s_waitcnt lgkmcnt(0)" ::: "memory");
}

__device__ __forceinline__ void my_sincos(float x, float& s, float& c) {
    const float q = rintf(x * 0.636619772367581f);
    float r = fmaf(-q, 1.5703125f, x); r = fmaf(-q, 4.837512969970703e-4f, r); r = fmaf(-q, 7.549789954891882e-8f, r);
    const float z = r * r;
    const float sp = r + r * z * (-1.6666654611e-1f + z * (8.3321608736e-3f + z * (-1.9515295891e-4f)));
    const float cp = 1.0f - 0.5f * z + z * z * (4.166664568298827e-2f + z * (-1.388731625493765e-3f + z * 2.443315711809948e-5f));
    const int qi = ((int)q) & 3;
    s = (qi == 0) ? sp : (qi == 1) ? cp : (qi == 2) ? -sp : -cp;
    c = (qi == 0) ? cp : (qi == 1) ? -sp : (qi == 2) ? -cp : sp;
}
__device__ __forceinline__ void s5_coeffs(const Args& A, int g, int p, float& ar, float& ai, float& fre, float& fim) {
    const float lr = A.in[7][g * NP + p], li = A.in[8][g * NP + p], dt = expf(A.in[9][g]);
    const float mag = expf(lr * dt); float s, c; my_sincos(li * dt, s, c); ar = mag * c; ai = mag * s;
    const float den = lr * lr + li * li, nr = ar - 1.0f, ni = ai;
    fre = (nr * lr + ni * li) / den; fim = (ni * lr - nr * li) / den;
}

__device__ __forceinline__ void prologue(LAS unsigned char* lds, const Args& A, int G) {
    const int tid = threadIdx.x, lane = tid & 63, wave = __builtin_amdgcn_readfirstlane(tid >> 6);
    unsigned char* ws = A.ws;
    LAS float* scr = (LAS float*)(lds + wave * 16384);
    const int gw = blockIdx.x * NWAVES + wave, NGW = G * NWAVES;
    constexpr int I_GU = (DM / 64) * (DFF / 32), I_DN = (DFF / 64) * (DM / 32), I_IN = (DM / 64) * (NIN / 32), I_GL = (S5W / 64) * (S5W / 32), I_OUT = (DM / 64) * (DM / 32);
    constexpr int NITEMS = 4 * I_GU + 2 * I_DN + I_IN + I_GL + I_OUT;
    for (int it = gw; it < NITEMS; it += NGW) {
        int r = it;
        if (r < I_GU) { transpose_item(A.in[2], DM, DFF, A.in[1], (bf16*)(ws + WS_W1GU), 1, scr, r, lane); continue; } r -= I_GU;
        if (r < I_GU) { transpose_item(A.in[3], DM, DFF, A.in[1], (bf16*)(ws + WS_W1GU), 2, scr, r, lane); continue; } r -= I_GU;
        if (r < I_DN) { transpose_item(A.in[4], DFF, DM, nullptr, (bf16*)(ws + WS_W1D), 0, scr, r, lane); continue; } r -= I_DN;
        if (r < I_IN) { transpose_item(A.in[6], DM, NIN, A.in[5], (bf16*)(ws + WS_WIN), 3, scr, r, lane); continue; } r -= I_IN;
        if (r < I_GL) { transpose_item(A.in[15], S5W, S5W, nullptr, (bf16*)(ws + WS_WGLU), 0, scr, r, lane); continue; } r -= I_GL;
        if (r < I_OUT) { transpose_item(A.in[21], DM, DM, nullptr, (bf16*)(ws + WS_WOUT), 0, scr, r, lane); continue; } r -= I_OUT;
        if (r < I_GU) { transpose_item(A.in[23], DM, DFF, A.in[22], (bf16*)(ws + WS_W2GU), 1, scr, r, lane); continue; } r -= I_GU;
        if (r < I_GU) { transpose_item(A.in[24], DM, DFF, A.in[22], (bf16*)(ws + WS_W2GU), 2, scr, r, lane); continue; } r -= I_GU;
        transpose_item(A.in[25], DFF, DM, nullptr, (bf16*)(ws + WS_W2D), 0, scr, r, lane);
    }
    float* ss = (float*)(ws + WS_SS);
    bf16* XB = (bf16*)(ws + WS_XB);
    for (int row = 4 * gw; row < MTOK; row += 4 * NGW) {
        f32x4 v[4][4];
#pragma unroll
        for (int r = 0; r < 4; ++r) { const f32x4* xr = (const f32x4*)(A.in[0] + (size_t)(row + r) * DM) + lane;
#pragma unroll
            for (int j = 0; j < 4; ++j) v[r][j] = __builtin_nontemporal_load(&xr[64 * j]); }
#pragma unroll
        for (int r = 0; r < 4; ++r) { float sq = 0.f;
#pragma unroll
            for (int j = 0; j < 4; ++j) sq += (v[r][j][0] * v[r][j][0] + v[r][j][1] * v[r][j][1]) + (v[r][j][2] * v[r][j][2] + v[r][j][3] * v[r][j][3]);
            sq = wave_sum(sq);
            if (lane == 0) ss[row + r] = sq;
            u32x2* o = (u32x2*)(XB + (size_t)(row + r) * DM) + lane;
#pragma unroll
            for (int j = 0; j < 4; ++j) { u32x2 w; w.x = pg8::cvt_pk_bf16(v[r][j][0], v[r][j][1]); w.y = pg8::cvt_pk_bf16(v[r][j][2], v[r][j][3]); o[64 * j] = w; } }
    }
    const int gt = blockIdx.x * (NWAVES * 64) + tid, NT = G * NWAVES * 64;
    for (int i = gt; i < 3 * MTOK; i += NT) ss[MTOK + i] = 0.f;
    f32x2* abar = (f32x2*)(ws + WS_S5A); f32x2* abarT = (f32x2*)(ws + WS_S5AT);
    u32x4* bfrag = (u32x4*)(ws + WS_S5BF); u32x4* cfrag = (u32x4*)(ws + WS_S5CF);
    for (int i = gt; i < NG * NP; i += NT) {
        const int g = i / NP, p = i % NP; float ar, ai, fre, fim; s5_coeffs(A, g, p, ar, ai, fre, fim);
        abar[i] = (f32x2){ar, ai};
        float tr = ar, ti = ai;
#pragma unroll
        for (int k = 0; k < 5; ++k) { const float nr = tr * tr - ti * ti, ni = 2.0f * tr * ti; tr = nr; ti = ni; }
        abarT[i] = (f32x2){tr, ti};
    }
    for (int i = gt; i < NG * 8 * 64; i += NT) {
        const int ln = i & 63, nt = (i >> 6) & 7, g = i >> 9, p = 16 * (nt & 3) + (ln & 15), c0 = 8 * (ln >> 4);
        u32x4 o = (u32x4){0u, 0u, 0u, 0u};
        if (c0 < 16) {
            float ar, ai, fre, fim; s5_coeffs(A, g, p, ar, ai, fre, fim);
            const float* br = A.in[10] + ((size_t)g * NP + p) * NC + c0; const float* bi = A.in[11] + ((size_t)g * NP + p) * NC + c0;
            float v[8];
#pragma unroll
            for (int k = 0; k < 8; ++k) v[k] = (nt < 4) ? (fre * br[k] - fim * bi[k]) : (fre * bi[k] + fim * br[k]);
            o.x = pk2(v[0], v[1]); o.y = pk2(v[2], v[3]); o.z = pk2(v[4], v[5]); o.w = pk2(v[6], v[7]);
        }
        bfrag[i] = o;
    }
    for (int i = gt; i < NG * 4 * 64; i += NT) {
        const int ln = i & 63, ks = (i >> 6) & 3, g = i >> 8, c = ln & 15, p0 = 16 * ks + 4 * (ln >> 4);
        const float* cr = A.in[12] + ((size_t)g * NC + c) * NP + p0; const float* ci = A.in[13] + ((size_t)g * NC + c) * NP + p0;
        u32x4 o; o.x = pk2(cr[0], -ci[0]); o.y = pk2(cr[1], -ci[1]); o.z = pk2(cr[2], -ci[2]); o.w = pk2(cr[3], -ci[3]);
        cfrag[i] = o;
    }
}

constexpr int XS_PITCH = 68;
constexpr int XS_WAVE_BYTES = 32 * XS_PITCH * 4;
constexpr int CARRY_OFF = NWAVES * XS_WAVE_BYTES;
__device__ __forceinline__ void s5_phase(LAS unsigned char* lds, const Args& A, int G) {
    const int tid = threadIdx.x, lane = tid & 63, w = __builtin_amdgcn_readfirstlane(tid >> 6), fr = lane & 15, fq = lane >> 4;
    unsigned char* ws = A.ws;
    LAS unsigned* xs = (LAS unsigned*)(lds + w * XS_WAVE_BYTES);
    LAS f32x2* carry = (LAS f32x2*)(lds + CARRY_OFF);
    const f32x2* abar = (const f32x2*)(ws + WS_S5A); const f32x2* abarT = (const f32x2*)(ws + WS_S5AT);
    const bf16x8* bfrag = (const bf16x8*)(ws + WS_S5BF); const bf16x8* cfrag = (const bf16x8*)(ws + WS_S5CF);
    const bf16* U = (const bf16*)(ws + WS_U); bf16* YS = (bf16*)(ws + WS_YS);
    for (int item = blockIdx.x; item < BATCH * NG; item += G) {
        const int b = item / NG, g = item % NG;
        const f32x2 a = abar[g * NP + lane], aT = abarT[g * NP + lane];
        bf16x8 bfr[8], cfr[4];
#pragma unroll
        for (int nt = 0; nt < 8; ++nt) bfr[nt] = bfrag[(g * 8 + nt) * 64 + lane];
#pragma unroll
        for (int ks = 0; ks < 4; ++ks) cfr[ks] = cfrag[(g * 4 + ks) * 64 + lane];
        const f32x4 dsk = *(const f32x4*)(A.in[14] + g * NC + 4 * fq);
        const bf16* Ub = U + (size_t)b * SEQ * S5W + g * NC;
        bf16* Yb = YS + (size_t)b * SEQ * S5W + g * NC;
        float xr = 0.f, xi = 0.f;
        bf16x8 uf[2]; u32x2 usk[2];
#pragma unroll
        for (int mt = 0; mt < 2; ++mt) { const size_t t = (size_t)(32 * w + 16 * mt + fr);
            uf[mt] = (bf16x8){0, 0, 0, 0, 0, 0, 0, 0}; if (fq < 2) uf[mt] = *(const bf16x8*)(Ub + t * S5W + 8 * fq);
            usk[mt] = *(const u32x2*)(Ub + t * S5W + 4 * fq); }
        for (int sc = 0; sc < 16; ++sc) {
            const int tb = sc * 256 + 32 * w;
#pragma unroll
            for (int mt = 0; mt < 2; ++mt)
#pragma unroll
                for (int nt = 0; nt < 4; ++nt) {
                    const f32x4 z4 = (f32x4){0.f, 0.f, 0.f, 0.f};
                    const f32x4 dre = __builtin_amdgcn_mfma_f32_16x16x32_bf16(bfr[nt], uf[mt], z4, 0, 0, 0);
                    const f32x4 dim = __builtin_amdgcn_mfma_f32_16x16x32_bf16(bfr[4 + nt], uf[mt], z4, 0, 0, 0);
                    u32x4 wv; wv.x = pg8::cvt_pk_bf16(dre[0], dim[0]); wv.y = pg8::cvt_pk_bf16(dre[1], dim[1]); wv.z = pg8::cvt_pk_bf16(dre[2], dim[2]); wv.w = pg8::cvt_pk_bf16(dre[3], dim[3]);
                    *(LAS u32x4*)(xs + (16 * mt + fr) * XS_PITCH + 16 * nt + 4 * fq) = wv;
                }
            const u32x2 usk_cur0 = usk[0], usk_cur1 = usk[1];
            if (sc + 1 < 16) {
#pragma unroll
                for (int mt = 0; mt < 2; ++mt) { const size_t t = (size_t)(tb + 256 + 16 * mt + fr);
                    if (fq < 2) uf[mt] = *(const bf16x8*)(Ub + t * S5W + 8 * fq);
                    usk[mt] = *(const u32x2*)(Ub + t * S5W + 4 * fq); }
            }
            unsigned v[32];
#pragma unroll
            for (int t = 0; t < 32; ++t) v[t] = xs[t * XS_PITCH + lane];
            float sr = 0.f, si = 0.f;
#pragma unroll
            for (int t = 0; t < 32; ++t) { const float br = __uint_as_float(v[t] << 16), bi = __uint_as_float(v[t] & 0xffff0000u);
                const float nr = fmaf(-a.y, si, fmaf(a.x, sr, br)), ni = fmaf(a.y, sr, fmaf(a.x, si, bi)); sr = nr; si = ni; }
            carry[(sc & 1) * 512 + w * 64 + lane] = (f32x2){sr, si};
            __syncthreads();
            float cr = xr, ci = xi, mr = 0.f, mi = 0.f;
#pragma unroll
            for (int vv = 0; vv < 8; ++vv) { if (vv == w) { mr = cr; mi = ci; }
                const f32x2 e = carry[(sc & 1) * 512 + vv * 64 + lane];
                const float nr = fmaf(-aT.y, ci, fmaf(aT.x, cr, e.x)), ni = fmaf(aT.y, cr, fmaf(aT.x, ci, e.y)); cr = nr; ci = ni; }
            xr = cr; xi = ci;
            sr = mr; si = mi;
#pragma unroll
            for (int t = 0; t < 32; ++t) { const float br = __uint_as_float(v[t] << 16), bi = __uint_as_float(v[t] & 0xffff0000u);
                const float nr = fmaf(-a.y, si, fmaf(a.x, sr, br)), ni = fmaf(a.y, sr, fmaf(a.x, si, bi)); sr = nr; si = ni;
                xs[t * XS_PITCH + lane] = pg8::cvt_pk_bf16(sr, si); }
#pragma unroll
            for (int mt = 0; mt < 2; ++mt) {
                f32x4 d = (f32x4){0.f, 0.f, 0.f, 0.f};
#pragma unroll
                for (int ks = 0; ks < 4; ++ks) { const bf16x8 xf = *(const LAS bf16x8*)(xs + (16 * mt + fr) * XS_PITCH + 16 * ks + 4 * fq);
                    d = __builtin_amdgcn_mfma_f32_16x16x32_bf16(cfr[ks], xf, d, 0, 0, 0); }
                const u32x2 uu = mt ? usk_cur1 : usk_cur0;
                float y[4];
#pragma unroll
                for (int j = 0; j < 4; ++j) { const unsigned wd = uu[j >> 1]; const float uval = __uint_as_float((j & 1) ? (wd & 0xffff0000u) : (wd << 16));
                    const float yy = d[j] + dsk[j] * uval; const float zz = 1.5957691216f * (yy + 0.044715f * yy * yy * yy);
                    y[j] = yy * __builtin_amdgcn_rcpf(1.0f + __expf(-zz)); }
                u32x2 o; o.x = pg8::cvt_pk_bf16(y[0], y[1]); o.y = pg8::cvt_pk_bf16(y[2], y[3]);
                __builtin_nontemporal_store(o, (u32x2*)(Yb + (size_t)(tb + 16 * mt + fr) * S5W + 4 * fq));
            }
        }
    }
    __syncthreads();
}

__device__ __forceinline__ float half_sum(float v) {
    v += dpp_mov<0xB1>(v); v += dpp_mov<0x4E>(v); v += dpp_mov<0x141>(v); v += dpp_mov<0x140>(v);
    v += __shfl_xor(v, 16);
    return v;
}
__device__ __forceinline__ void conv_phase(const Args& A, int G) {
    const int tid = threadIdx.x, lane = tid & 63, wave = __builtin_amdgcn_readfirstlane(tid >> 6);
    unsigned char* ws = A.ws;
    const bf16* Z = (const bf16*)(ws + WS_Z); bf16* YM = (bf16*)(ws + WS_YM);
    const int gw = blockIdx.x * NWAVES + wave, NGW = G * NWAVES;
    constexpr int TT = 16, NTILE = 4, SEGT = TT * NTILE;
    for (int item = gw; item < BATCH * 4 * (SEQ / SEGT); item += NGW) {
        const int seg = item & (SEQ / SEGT - 1), hp = (item >> 6) & 3, b = item >> 8, ch0 = hp * 128 + 2 * lane;
        f32x2 wk[CK];
#pragma unroll
        for (int k = 0; k < CK; ++k) wk[k] = *(const f32x2*)(A.in[17] + k * CVW + ch0);
        const f32x2 bias = *(const f32x2*)(A.in[18] + ch0), lg = *(const f32x2*)(A.in[19] + ch0), lb = *(const f32x2*)(A.in[20] + ch0);
        const bf16* zp = Z + (size_t)b * SEQ * CVW + hp * 128;
        bf16* op = YM + (size_t)b * SEQ * DM + 512 + hp * 128;
        const int t0 = seg * SEGT;
        f32x2 wp[30 + TT];
#pragma unroll
        for (int i = 0; i < 30; ++i) wp[i] = (f32x2){0.f, 0.f};
        if (t0 > 0) {
#pragma unroll
            for (int i = 0; i < 30; ++i) { const unsigned wv = __builtin_nontemporal_load(&((const unsigned*)(zp + (size_t)(t0 - 30 + i) * CVW))[lane]);
                wp[i] = (f32x2){__uint_as_float(wv << 16), __uint_as_float(wv & 0xffff0000u)}; }
        }
#pragma unroll 1
        for (int tt = 0; tt < NTILE; ++tt) {
            const int tb = t0 + TT * tt;
#pragma unroll
            for (int i = 0; i < TT; ++i) { const unsigned wv = __builtin_nontemporal_load(&((const unsigned*)(zp + (size_t)(tb + i) * CVW))[lane]);
                wp[30 + i] = (f32x2){__uint_as_float(wv << 16), __uint_as_float(wv & 0xffff0000u)}; }
#pragma unroll
            for (int i = 0; i < TT; ++i) {
                f32x2 acc = bias;
#pragma unroll
                for (int k = 0; k < CK; ++k) acc = __builtin_elementwise_fma(wk[k], wp[i + k], acc);
                const float s1 = half_sum(acc.x + acc.y), s2 = half_sum(fmaf(acc.x, acc.x, acc.y * acc.y));
                const float mean = s1 * (1.0f / 64.0f);
                const float var = fmaxf(s2 * (1.0f / 64.0f) - mean * mean, 0.0f);
                const float rstd = __builtin_amdgcn_rsqf(var + EPS);
                const f32x2 zn = (acc - mean) * rstd * lg + lb;
                f32x2 y; y.x = zn.x * __builtin_amdgcn_rcpf(1.0f + __expf(-zn.x)); y.y = zn.y * __builtin_amdgcn_rcpf(1.0f + __expf(-zn.y));
                __builtin_nontemporal_store(pg8::cvt_pk_bf16(y.x, y.y), &((unsigned*)(op + (size_t)(tb + i) * DM))[lane]);
            }
#pragma unroll
            for (int i = 0; i < 30; ++i) wp[i] = wp[TT + i];
        }
    }
}

__device__ __forceinline__ void final_phase(const Args& A, int G, int ssi = 3) {
    const int tid = threadIdx.x, lane = tid & 63, wave = __builtin_amdgcn_readfirstlane(tid >> 6);
    const float* ss4 = (const float*)(A.ws + WS_SS) + ssi * MTOK;
    const int gw = blockIdx.x * NWAVES + wave, NGW = G * NWAVES;
    f32x4 gv[4];
#pragma unroll
    for (int j = 0; j < 4; ++j) gv[j] = ((const f32x4*)A.in[26])[64 * j + lane];
    const bf16* XBf = (const bf16*)(A.ws + WS_XB);
    const bool xmap = (G == 256);
    const int xq = blockIdx.x & 7, jq = (blockIdx.x >> 3) * NWAVES + wave;
    for (int it = 0; it < (xmap ? 4 : 0x7fffffff); ++it) {
        const int row = xmap ? (4096 * xq + 1024 * it + 4 * jq) : (4 * gw + it * 4 * NGW);
        if (row >= MTOK) break;
        u32x2 w[4][4]; float rs[4];
#pragma unroll
        for (int r = 0; r < 4; ++r) { const u32x2* xi = (const u32x2*)(XBf + (size_t)(row + r) * DM) + lane; rs[r] = ss4[row + r];
#pragma unroll
            for (int j = 0; j < 4; ++j) w[r][j] = __builtin_nontemporal_load(&xi[64 * j]); }
#pragma unroll
        for (int r = 0; r < 4; ++r) { const float rr = __builtin_amdgcn_rsqf(rs[r] * (1.0f / 1024.0f) + EPS);
            f32x4* o = (f32x4*)(A.out + (size_t)(row + r) * DM) + lane;
#pragma unroll
            for (int j = 0; j < 4; ++j) { const u32x2 ww = w[r][j];
                const f32x4 v = (f32x4){__uint_as_float(ww.x << 16), __uint_as_float(ww.x & 0xffff0000u), __uint_as_float(ww.y << 16), __uint_as_float(ww.y & 0xffff0000u)};
                __builtin_nontemporal_store(v * rr * gv[j], &o[64 * j]); } }
    }
}


#define GAS __attribute__((address_space(1)))
constexpr size_t WS_CTL = 0, CTL_ZERO_BYTES = 65536;
constexpr int MISC_OFF = 131072 + 320;
#define XB_TMO      128
#define XB_XCNT(j)  (256  + 64 * (j))
#define XB_XSUB(j)  (1280 + 64 * (j))
#define XB_XGEN(j)  (2304 + 64 * (j))
#define XB_TOP      3328
#define XB_TOPGEN   3392
#define XCD_BAR_WORDS 3456
#define XB_SPIN_CAP (1u << 18)

__device__ __forceinline__ unsigned xb_ld(unsigned* p)              { return __hip_atomic_load(p, __ATOMIC_RELAXED, __HIP_MEMORY_SCOPE_AGENT); }
__device__ __forceinline__ unsigned xb_add(unsigned* p, unsigned v) { return __hip_atomic_fetch_add(p, v, __ATOMIC_RELAXED, __HIP_MEMORY_SCOPE_AGENT); }
__device__ __forceinline__ unsigned xb_xcc_id() { return (unsigned)__builtin_amdgcn_s_getreg((3 << 11) | 20) & 0xFu; }
#define XB_SPIN(cond, bar) do { unsigned _sp = 0; while (cond) { __builtin_amdgcn_s_sleep(1); \
    if ((++_sp & 255u) == 0u) { if (xb_ld(&(bar)[XB_TMO])) break; if (_sp > XB_SPIN_CAP) { atomicAdd(&(bar)[XB_TMO], 1u); break; } } } } while (0)

struct XcdBarrier {
    unsigned* bar; unsigned x;
    volatile LAS unsigned* st;
};

__device__ __forceinline__ XcdBarrier xcd_barrier_post(unsigned* bar, volatile LAS unsigned* st) {
    XcdBarrier b; b.bar = bar; b.x = xb_xcc_id(); b.st = st;
    if (threadIdx.x == 0) (void)xb_add(&bar[XB_XCNT(b.x)], 1u);
    return b;
}
__device__ __forceinline__ void xcd_barrier_complete(unsigned* bar, unsigned x, unsigned& nloc, unsigned& nx) {
    const unsigned G = gridDim.x * gridDim.y * gridDim.z;
    unsigned sum, cnt, mine, sp = 0u;
    for (;;) {
        sum = 0u; cnt = 0u; mine = 0u;
#pragma unroll
        for (unsigned j = 0; j < 16; ++j) { const unsigned c = xb_ld(&bar[XB_XCNT(j)]); sum += c; cnt += (c > 0u) ? 1u : 0u; mine = (j == x) ? c : mine; }
        if (sum == G) break;
        __builtin_amdgcn_s_sleep(1);
        if ((++sp & 255u) == 0u) { if (xb_ld(&bar[XB_TMO])) break; if (sp > XB_SPIN_CAP) { atomicAdd(&bar[XB_TMO], 1u); break; } }
    }
    nloc = mine > 0u ? mine : 1u; nx = cnt > 0u ? cnt : 1u;
}

__device__ __forceinline__ void xcd_barrier(const XcdBarrier& b) {
    asm volatile("s_waitcnt vmcnt(0)" ::: "memory");
    __syncthreads();
    if (threadIdx.x == 0) {
        unsigned* bar = b.bar;
        __builtin_amdgcn_s_waitcnt(0);
        unsigned nloc = b.st[0], nx = b.st[1];
        if (nloc == 0u) { xcd_barrier_complete(bar, b.x, nloc, nx); b.st[0] = nloc; b.st[1] = nx; }
        const unsigned old = xb_add(&bar[XB_XSUB(b.x)], 1u);
        const unsigned gen = old / nloc;
        if (old + 1u == (gen + 1u) * nloc) {
            __builtin_amdgcn_fence(__ATOMIC_RELEASE, "agent");
            asm volatile("s_waitcnt vmcnt(0)" ::: "memory");
            const unsigned og = xb_add(&bar[XB_TOP], 1u);
            const unsigned tg = og / nx;
            if (og + 1u == (tg + 1u) * nx) xb_add(&bar[XB_TOPGEN], 1u);
            else XB_SPIN(xb_ld(&bar[XB_TOPGEN]) == tg, bar);
            __builtin_amdgcn_fence(__ATOMIC_ACQUIRE, "agent");
            xb_add(&bar[XB_XGEN(b.x)], 1u);
            asm volatile("s_waitcnt vmcnt(0)" ::: "memory");
        } else {
            XB_SPIN(xb_ld(&bar[XB_XGEN(b.x)]) == gen, bar);
            __builtin_amdgcn_fence(__ATOMIC_ACQUIRE, "agent");
            asm volatile("s_waitcnt vmcnt(0)" ::: "memory");
        }
    }
    __syncthreads();
}

__device__ __forceinline__ void dbg_dump(const Args& A, int G, const bf16* a, int lda, const bf16* b, int ldb) {
    const int gt = blockIdx.x * (NWAVES * 64) + threadIdx.x, NT = G * NWAVES * 64;
    for (size_t i = gt; i < (size_t)MTOK * DM; i += NT) { const size_t row = i >> 10; const int c = (int)(i & 1023);
        A.out[i] = (c < 512) ? bf2f(a[row * lda + c]) : bf2f(b[row * ldb + (c - 512)]); }
}
constexpr int N_PHASES = 10;
__global__ void __launch_bounds__(NWAVES * 64, 2) mk_fwd(Args args) {
    extern __shared__ __attribute__((aligned(16))) unsigned char lds_raw[];
    LAS unsigned char* lds = (LAS unsigned char*)lds_raw;
    const int G = gridDim.x, lo = args.ph_lo, hi = args.ph_hi;
    unsigned char* ws = args.ws;
    float* ss = (float*)(ws + WS_SS);
    bf16* XB = (bf16*)(ws + WS_XB); bf16* A1 = (bf16*)(ws + WS_A1);
#if MK_MULTI
#define GRID_SYNC() do { } while (0)
#else
    volatile LAS unsigned* MISC = (volatile LAS unsigned*)(lds + MISC_OFF);
    if (threadIdx.x < 32) MISC[threadIdx.x] = 0u;
    __syncthreads();
    XcdBarrier bar = xcd_barrier_post((unsigned*)(ws + WS_CTL), MISC + 8);
#define GRID_SYNC() xcd_barrier(bar)
#endif
#define IN(k) (lo <= (k) && (k) < hi)
    if (IN(0)) { prologue(lds, args, G); __syncthreads(); GRID_SYNC(); }
    if (IN(1)) {
        pg8::Gemm g{XB, (const bf16*)(ws + WS_W1GU), MTOK, 2 * DFF, DM}; pg8::StaticOrder S; S.init(MTOK, 2 * DFF, G, (int)blockIdx.x, GU_WGM);
        pg8::EpiSwiGLU E{A1, DFF, ss};
        pg8::gemm_phase<pg8::EpiSwiGLU, pg8::StaticOrder, true, true>(lds, g, S, E);
        GRID_SYNC();
    }
    if (IN(2)) {
        pg8::Gemm g{A1, (const bf16*)(ws + WS_W1D), MTOK, DM, DFF}; pg8::StaticOrder S; S.init(MTOK, DM, G, (int)blockIdx.x, 8, 1);
        pg8::EpiResid E{XB, ss + MTOK, 0.5f};
        pg8::gemm_phase<pg8::EpiResid, pg8::StaticOrder, true, true>(lds, g, S, E);
        GRID_SYNC();
    }
#if DBG_STOP == 2
    if (IN(9)) final_phase(args, G, 1);
    return;
#endif
    if (IN(3)) {
        pg8::Gemm g{XB, (const bf16*)(ws + WS_WIN), MTOK, NIN, DM}; pg8::StaticOrder S; S.init(MTOK, NIN, G, (int)blockIdx.x);
        pg8::EpiWin E{(bf16*)(ws + WS_U), (bf16*)(ws + WS_Z), ss + MTOK};
        pg8::gemm_phase<pg8::EpiWin, pg8::StaticOrder, true, true>(lds, g, S, E);
        GRID_SYNC();
    }
#if DBG_STOP == 3
    if (IN(9)) dbg_dump(args, G, (const bf16*)(ws + WS_U), 512, (const bf16*)(ws + WS_Z), 512);
    return;
#endif
    if (IN(4)) { s5_phase(lds, args, G); conv_phase(args, G); GRID_SYNC(); }
#if DBG_STOP == 4
    if (IN(9)) dbg_dump(args, G, (const bf16*)(ws + WS_YS), 512, (const bf16*)(ws + WS_YM) + 512, 1024);
    return;
#endif
    if (IN(5)) {
        pg8::Gemm g{(const bf16*)(ws + WS_YS), (const bf16*)(ws + WS_WGLU), MTOK, S5W, S5W}; pg8::StaticOrder S; S.init(MTOK, S5W, G, (int)blockIdx.x);
        pg8::EpiGlu E{(const bf16*)(ws + WS_YS), (bf16*)(ws + WS_YM), args.in[16]};
        pg8::gemm_phase<pg8::EpiGlu, pg8::StaticOrder, true, true>(lds, g, S, E);
        GRID_SYNC();
    }
    if (IN(6)) {
        pg8::Gemm g{(const bf16*)(ws + WS_YM), (const bf16*)(ws + WS_WOUT), MTOK, DM, DM}; pg8::StaticOrder S; S.init(MTOK, DM, G, (int)blockIdx.x);
        pg8::EpiResid E{XB, ss + 2 * MTOK, 1.0f};
        pg8::gemm_phase<pg8::EpiResid, pg8::StaticOrder, true, true>(lds, g, S, E);
        GRID_SYNC();
    }
#if DBG_STOP == 6
    if (IN(9)) final_phase(args, G, 2);
    return;
#endif
    if (IN(7)) {
        pg8::Gemm g{XB, (const bf16*)(ws + WS_W2GU), MTOK, 2 * DFF, DM}; pg8::StaticOrder S; S.init(MTOK, 2 * DFF, G, (int)blockIdx.x, GU_WGM);
        pg8::EpiSwiGLU E{A1, DFF, ss + 2 * MTOK};
        pg8::gemm_phase<pg8::EpiSwiGLU, pg8::StaticOrder, true, true>(lds, g, S, E);
        GRID_SYNC();
    }
    if (IN(8)) {
        pg8::Gemm g{A1, (const bf16*)(ws + WS_W2D), MTOK, DM, DFF}; pg8::StaticOrder S; S.init(MTOK, DM, G, (int)blockIdx.x, 8, 1);
        pg8::EpiResid E{XB, ss + 3 * MTOK, 0.5f};
        pg8::gemm_phase<pg8::EpiResid, pg8::StaticOrder, true, true>(lds, g, S, E);
        GRID_SYNC();
    }
    if (IN(9)) final_phase(args, G);
#undef IN
}

extern "C" void kernel_launch(void* const* d_in, const int* in_sizes, int n_in, void* d_out, int out_size, void* d_ws, size_t ws_size, hipStream_t stream) {
    static int grid = 0;
    if (grid == 0) {
        if (n_in != 27 || out_size != MTOK * DM || ws_size < WS_END) { fprintf(stderr, "kernel_launch: unexpected shapes (n_in %d out %d ws %zu)\n", n_in, out_size, ws_size); grid = -1; return; }
        int dev = 0, cus = 0, per_cu = 0;
        hipGetDevice(&dev); hipDeviceGetAttribute(&cus, hipDeviceAttributeMultiprocessorCount, dev);
        if (hipFuncSetAttribute((const void*)mk_fwd, hipFuncAttributeMaxDynamicSharedMemorySize, LDS_BYTES) != hipSuccess) { fprintf(stderr, "kernel_launch: hipFuncSetAttribute failed\n"); grid = -1; return; }
        if (hipOccupancyMaxActiveBlocksPerMultiprocessor(&per_cu, (const void*)mk_fwd, NWAVES * 64, LDS_BYTES) != hipSuccess || per_cu < 1) { fprintf(stderr, "kernel_launch: occupancy query says %d\n", per_cu); per_cu = 1; }
        (void)hipGetLastError();
        grid = cus;
    }
    if (grid < 0) return;
    Args a{};
    for (int i = 0; i < 27; ++i) a.in[i] = (const float*)d_in[i];
    a.out = (float*)d_out; a.ws = (unsigned char*)d_ws;
#if MK_MULTI
    for (int p = 0; p < N_PHASES; ++p) { a.ph_lo = p; a.ph_hi = p + 1; hipLaunchKernelGGL(mk_fwd, dim3(grid), dim3(NWAVES * 64), LDS_BYTES, stream, a); }
#else
    a.ph_lo = 0; a.ph_hi = N_PHASES;
    if (hipMemsetAsync((char*)d_ws + WS_CTL, 0, CTL_ZERO_BYTES, stream) != hipSuccess) { fprintf(stderr, "kernel_launch: hipMemsetAsync failed\n"); return; }
    void* kargs[] = {&a};
    hipError_t e = hipLaunchCooperativeKernel((const void*)mk_fwd, dim3(grid), dim3(NWAVES * 64), kargs, LDS_BYTES, stream);
    if (e != hipSuccess) fprintf(stderr, "kernel_launch: cooperative launch failed: %s (grid %d)\n", hipGetErrorString(e), grid);
#endif
}
```

```cpp
#include <hip/hip_runtime.h>
#include <hip/hip_cooperative_groups.h>
#include <cstdio>
#include <cstdint>
namespace cg = cooperative_groups;

#ifndef GU_WGM
#define GU_WGM 4
#endif
#ifndef DBG_STOP
#define DBG_STOP 0
#endif
#ifndef MK_MULTI
#define MK_MULTI 0
#endif

namespace pg8 {
#define PG8_LAS __attribute__((address_space(3)))
typedef unsigned short bf16_t;
typedef short bf16x8 __attribute__((ext_vector_type(8)));
typedef float f32x4 __attribute__((ext_vector_type(4)));
typedef unsigned u32x4 __attribute__((ext_vector_type(4)));
constexpr int BM = 256, BK = 64, HALF = 128, HTB = HALF * BK * 2  , STAGE_BYTES = 8 * HTB, NXCD = 8, WGM = 8;

__host__ __device__ __forceinline__ int lds_byte(int r, int c) { const int st = (r >> 4) * 2 + (c >> 5), rr = r & 15, cc = c & 31, ob = rr * 64 + cc * 2; return st * 1024 + (ob ^ (((ob >> 9) & 1) << 5)); }
__host__ __device__ __forceinline__ void stage_rc(int b, int& R, int& C) { const int st = b / 1024, sb = b % 1024, swz = sb ^ (((sb >> 9) & 1) << 5); R = (st >> 1) * 16 + swz / 64; C = (st & 1) * 32 + (swz % 64) / 2; }
__host__ __device__ __forceinline__ int perm32(int rho) { const int n = rho >> 4, i = rho & 15; return 8 * (i >> 2) + 4 * n + (i & 3); }

struct Unit { int pm, pn; };
struct Gemm { const bf16_t* A; const bf16_t* Bt; int M, N, K; };

struct StaticOrder {
    int nM, nN, nwg, G, c, wgm, rev;
    __host__ __device__ void init(int M, int N, int G_, int c_, int wgm_ = WGM, int rev_ = 0) { nM = M / BM; nN = N / BM; nwg = nM * nN; G = G_; c = c_; wgm = wgm_; rev = rev_; }
    __host__ __device__ bool next(int i, Unit& u) const {
        const int nr = nwg / G; const bool rv = rev && (nwg % G == 0);
        const long L = (long)((rv && i < nr) ? nr - 1 - i : i) * G + c; if (L >= nwg) return false;
        int wgid = (int)L; { const int q = nwg / NXCD, r = nwg % NXCD, xcd = wgid % NXCD, off = wgid / NXCD; wgid = (xcd < r ? xcd * (q + 1) : r * (q + 1) + (xcd - r) * q) + off; }
        const int nig = wgm * nN, gid = wgid / nig, fm = gid * wgm, gsz = (nM - fm) < wgm ? (nM - fm) : wgm;
        u.pm = fm + ((wgid % nig) % gsz); u.pn = (wgid % nig) / gsz; return true;
    }
    __device__ __forceinline__ void a_ready(const Unit&) const {}
    __device__ __forceinline__ void done(const Unit&) const {}
};

typedef __bf16 bf16v2_t __attribute__((ext_vector_type(2)));
typedef float f32v2_t __attribute__((ext_vector_type(2)));
__device__ __forceinline__ unsigned cvt_pk_bf16(float lo, float hi) { const f32v2_t f = {lo, hi}; const bf16v2_t r = __builtin_convertvector(f, bf16v2_t); return __builtin_bit_cast(unsigned, r); }
typedef float f32x2 __attribute__((ext_vector_type(2)));
typedef unsigned u32x2 __attribute__((ext_vector_type(2)));
template <class Epi, class Sched, bool ALIGN_EPI = false, bool SP2 = false>
__device__ __forceinline__ void gemm_phase(PG8_LAS unsigned char* lds, const Gemm g, const Sched& S, const Epi& E) {
    const int tid = threadIdx.x, wid = __builtin_amdgcn_readfirstlane(tid >> 6), lane = tid & 63, wr = wid >> 2, wc = wid & 3, fr = lane & 15, fq = lane >> 4;
    const int K = g.K, nt = K / BK;
    unsigned voffA[2], voffB[2];
#pragma unroll
    for (int i = 0; i < 2; ++i) { int R, C; stage_rc(tid * 16 + i * 8192, R, C); const int Rb = Epi::PERM ? ((R & ~31) + perm32(R & 31)) : R;
        voffA[i] = (unsigned)(R * K + C) * 2u; voffB[i] = (unsigned)(Rb * K + C) * 2u; }
    const size_t kstep = (size_t)(BK * 2);
    const size_t hstep = (size_t)HALF * K * 2;
    const size_t tstep = 2 * hstep;
    const unsigned ldsw = (unsigned)wid * 1024u;
    const int aoff = lds_byte(wr * 64 + fr, fq * 8), boff = lds_byte(wc * 32 + fr, fq * 8);
#define PG8_SA(b, h) (((b) * 2 + (h)) * HTB)
#define PG8_SB(b, h) ((4 + (b) * 2 + (h)) * HTB)
#define PG8_STAGE(bufoff, gbase, voff) do { _Pragma("unroll") for (int _i = 0; _i < 2; ++_i) \
        __builtin_amdgcn_global_load_lds((const unsigned*)((const char*)(gbase) + (voff)[_i]), (PG8_LAS unsigned*)(lds + (bufoff) + ldsw + _i * 8192), 16, 0, 0); } while (0)
#define PG8_LDA(dst, b, h) do { _Pragma("unroll") for (int m = 0; m < 4; ++m) _Pragma("unroll") for (int k = 0; k < 2; ++k) dst[m][k] = *(const PG8_LAS bf16x8*)(lds + PG8_SA(b, h) + aoff + m * 2048 + k * 1024); } while (0)
#define PG8_LDB(dst, b, h) do { _Pragma("unroll") for (int n = 0; n < 2; ++n) _Pragma("unroll") for (int k = 0; k < 2; ++k) dst[n][k] = *(const PG8_LAS bf16x8*)(lds + PG8_SB(b, h) + boff + n * 2048 + k * 1024); } while (0)
#define PG8_MMA(ai, bj, At, Bt) do { __builtin_amdgcn_s_setprio(1); _Pragma("unroll") for (int m = 0; m < 4; ++m) _Pragma("unroll") for (int n = 0; n < 2; ++n) _Pragma("unroll") for (int k = 0; k < 2; ++k) \
        acc[ai][bj][m][n] = __builtin_amdgcn_mfma_f32_16x16x32_bf16(Bt[n][k], At[m][k], acc[ai][bj][m][n], 0, 0, 0); __builtin_amdgcn_s_setprio(0); } while (0)
#define PG8_WAIT_V(n) asm volatile("s_waitcnt vmcnt(" #n ")" ::: "memory")
#define PG8_WAIT_L(n) asm volatile("s_waitcnt lgkmcnt(" #n ")" ::: "memory")
#define PG8_BAR __builtin_amdgcn_s_barrier()
#define PG8_SCHED __builtin_amdgcn_sched_barrier(0)
    Unit cur, nxt; int ui = 0;
    if (!S.next(0, cur)) return;
    f32x4 acc[2][2][4][2];
#pragma unroll
    for (int a = 0; a < 2; ++a)
#pragma unroll
        for (int b = 0; b < 2; ++b)
#pragma unroll
            for (int m = 0; m < 4; ++m)
#pragma unroll
                for (int n = 0; n < 2; ++n) acc[a][b][m][n] = (f32x4){0.f, 0.f, 0.f, 0.f};
    bf16x8 At[4][2], B0[2][2], B1[2][2];
    const char* cA = (const char*)g.A + (size_t)cur.pm * tstep; const char* cB = (const char*)g.Bt + (size_t)cur.pn * tstep;
    S.a_ready(cur);
    if constexpr (SP2) {
        PG8_STAGE(PG8_SB(0, 0), cB, voffB); PG8_STAGE(PG8_SB(0, 1), cB + hstep, voffB); PG8_STAGE(PG8_SA(0, 0), cA, voffA); PG8_STAGE(PG8_SA(0, 1), cA + hstep, voffA);
        if (wr == 1) PG8_BAR;
        PG8_WAIT_V(2); PG8_BAR;
        PG8_STAGE(PG8_SB(1, 0), cB + kstep, voffB); PG8_STAGE(PG8_SA(1, 0), cA + kstep, voffA); PG8_STAGE(PG8_SB(1, 1), cB + hstep + kstep, voffB);
        PG8_WAIT_V(6); PG8_BAR;
    } else {
        PG8_STAGE(PG8_SB(0, 0), cB, voffB); PG8_STAGE(PG8_SA(0, 0), cA, voffA); PG8_STAGE(PG8_SB(0, 1), cB + hstep, voffB); PG8_STAGE(PG8_SA(0, 1), cA + hstep, voffA);
        if (wr == 1) PG8_BAR;
        PG8_WAIT_V(4); PG8_BAR;
        PG8_STAGE(PG8_SB(1, 0), cB + kstep, voffB); PG8_STAGE(PG8_SA(1, 0), cA + kstep, voffA); PG8_STAGE(PG8_SB(1, 1), cB + hstep + kstep, voffB);
        PG8_WAIT_V(6); PG8_BAR;
    }
    for (;;) {
        const bool has_next = S.next(ui + 1, nxt);
        const char* nA = has_next ? (const char*)g.A + (size_t)nxt.pm * tstep : cA; const char* nB = has_next ? (const char*)g.Bt + (size_t)nxt.pn * tstep : cB;
        typename Epi::Pre pre; E.prefetch(cur, wr, wc, fr, fq, pre);
        for (int t = 0; t < nt; t += 2) {
            const bool last = (t == nt - 2);
            const char* a1 = cA + (size_t)(t + 1) * kstep;
            const char* a2 = last ? nA : cA + (size_t)(t + 2) * kstep; const char* b2 = last ? nB : cB + (size_t)(t + 2) * kstep;
            const char* a3 = a2 + kstep; const char* b3 = b2 + kstep;
            if (last && has_next) S.a_ready(nxt);
            if constexpr (SP2) {
            PG8_LDB(B0, 0, 0); PG8_LDB(B1, 0, 1); PG8_SCHED; PG8_LDA(At, 0, 0); PG8_STAGE(PG8_SA(1, 1), a1 + hstep, voffA);
            PG8_WAIT_V(8); PG8_WAIT_L(0); PG8_BAR; PG8_MMA(0, 0, At, B0); PG8_MMA(0, 1, At, B1); PG8_BAR; PG8_SCHED;
            PG8_LDA(At, 0, 1); PG8_STAGE(PG8_SB(0, 0), b2, voffB); PG8_STAGE(PG8_SB(0, 1), b2 + hstep, voffB); PG8_STAGE(PG8_SA(0, 0), a2, voffA);
            PG8_WAIT_V(8); PG8_WAIT_L(0); PG8_BAR; PG8_MMA(1, 0, At, B0); PG8_MMA(1, 1, At, B1); PG8_BAR; PG8_SCHED;
            PG8_LDB(B0, 1, 0); PG8_LDB(B1, 1, 1); PG8_SCHED; PG8_LDA(At, 1, 0); PG8_STAGE(PG8_SA(0, 1), a2 + hstep, voffA);
            PG8_WAIT_V(8); PG8_WAIT_L(0); PG8_BAR; PG8_MMA(0, 0, At, B0); PG8_MMA(0, 1, At, B1); PG8_BAR; PG8_SCHED;
            PG8_LDA(At, 1, 1); PG8_STAGE(PG8_SB(1, 0), b3, voffB); PG8_STAGE(PG8_SB(1, 1), b3 + hstep, voffB); PG8_STAGE(PG8_SA(1, 0), a3, voffA);
            PG8_WAIT_V(8); PG8_WAIT_L(0); PG8_BAR; PG8_MMA(1, 0, At, B0); PG8_MMA(1, 1, At, B1); PG8_BAR; PG8_SCHED;
            } else {
            PG8_LDB(B0, 0, 0); PG8_SCHED; PG8_LDA(At, 0, 0); PG8_STAGE(PG8_SA(1, 1), a1 + hstep, voffA);
            PG8_WAIT_L(8); PG8_BAR; PG8_WAIT_L(0); PG8_MMA(0, 0, At, B0); PG8_BAR; PG8_SCHED;
            PG8_LDB(B1, 0, 1); PG8_STAGE(PG8_SB(0, 0), b2, voffB);
            PG8_BAR; PG8_WAIT_L(0); PG8_MMA(0, 1, At, B1); PG8_BAR;
            PG8_LDA(At, 0, 1); PG8_STAGE(PG8_SA(0, 0), a2, voffA);
            PG8_BAR; PG8_WAIT_L(0); PG8_MMA(1, 0, At, B0); PG8_BAR; PG8_SCHED;
            PG8_STAGE(PG8_SB(0, 1), b2 + hstep, voffB);
            PG8_WAIT_V(6); PG8_BAR; PG8_MMA(1, 1, At, B1); PG8_BAR;
            PG8_LDB(B0, 1, 0); PG8_SCHED; PG8_LDA(At, 1, 0); PG8_STAGE(PG8_SA(0, 1), a2 + hstep, voffA);
            PG8_WAIT_L(8); PG8_BAR; PG8_WAIT_L(0); PG8_MMA(0, 0, At, B0); PG8_BAR; PG8_SCHED;
            PG8_LDB(B1, 1, 1); PG8_STAGE(PG8_SB(1, 0), b3, voffB);
            PG8_BAR; PG8_WAIT_L(0); PG8_MMA(0, 1, At, B1); PG8_BAR;
            PG8_LDA(At, 1, 1); PG8_STAGE(PG8_SA(1, 0), a3, voffA);
            PG8_BAR; PG8_WAIT_L(0); PG8_MMA(1, 0, At, B0); PG8_BAR; PG8_SCHED;
            PG8_STAGE(PG8_SB(1, 1), b3 + hstep, voffB);
            PG8_WAIT_V(6); PG8_BAR; PG8_MMA(1, 1, At, B1); PG8_BAR;
            }
        }
        if constexpr (ALIGN_EPI) { if (wr == 0) PG8_BAR; }
        if constexpr (!Epi::AFTER_DRAIN) { E(acc, cur, wr, wc, fr, fq, pre); S.done(cur); }
        if (!has_next) break;
#pragma unroll
        for (int a = 0; a < 2; ++a)
#pragma unroll
            for (int b = 0; b < 2; ++b)
#pragma unroll
                for (int m = 0; m < 4; ++m)
#pragma unroll
                    for (int n = 0; n < 2; ++n) acc[a][b][m][n] = (f32x4){0.f, 0.f, 0.f, 0.f};
        cur = nxt; cA = nA; cB = nB; ++ui;
        if constexpr (ALIGN_EPI) { if (wr == 1) PG8_BAR; }
    }
    PG8_WAIT_V(0);
    if constexpr (!ALIGN_EPI) { if (wr == 0) PG8_BAR; }
    PG8_BAR;
    if constexpr (Epi::AFTER_DRAIN) { E.fused(acc, cur, wr, wc, fr, fq, lds, wid, lane); S.done(cur); }
#undef PG8_SA
#undef PG8_SB
#undef PG8_STAGE
#undef PG8_LDA
#undef PG8_LDB
#undef PG8_MMA
#undef PG8_WAIT_V
#undef PG8_WAIT_L
#undef PG8_BAR
#undef PG8_SCHED
}
}

constexpr int DM = 1024, BATCH = 8, SEQ = 4096, MTOK = BATCH * SEQ, DFF = 2816, S5W = 512, CVW = 512, NIN = 1536;
constexpr int NG = 32, NP = 64, NC = 16, CK = 31;
constexpr float EPS = 1e-6f;
constexpr int NWAVES = 8;
constexpr int LDS_BYTES = 147456;

constexpr size_t MiB = 1u << 20;
constexpr size_t WS_SS = 1 * MiB;
constexpr size_t WS_S5A = 2 * MiB;
constexpr size_t WS_S5AT = WS_S5A + 16384;
constexpr size_t WS_S5BF = WS_S5A + 65536;
constexpr size_t WS_S5CF = WS_S5BF + 262144;
constexpr size_t WS_W1GU = 4 * MiB;
constexpr size_t WS_W1D = 15 * MiB;
constexpr size_t WS_WIN = 21 * MiB;
constexpr size_t WS_WGLU = 24 * MiB;
constexpr size_t WS_WOUT = 25 * MiB;
constexpr size_t WS_W2GU = 27 * MiB;
constexpr size_t WS_W2D = 38 * MiB;
constexpr size_t WS_XB = 48 * MiB;
constexpr size_t WS_A1 = 112 * MiB;
constexpr size_t WS_U = WS_A1 + 0 * MiB;
constexpr size_t WS_Z = WS_A1 + 32 * MiB;
constexpr size_t WS_YS = WS_A1 + 64 * MiB;
constexpr size_t WS_YM = WS_A1 + 96 * MiB;
constexpr size_t WS_END = 448 * MiB;

#define LAS __attribute__((address_space(3)))
typedef unsigned short bf16;
typedef float f32x4 __attribute__((ext_vector_type(4)));
typedef float f32x2 __attribute__((ext_vector_type(2)));
typedef short bf16x8 __attribute__((ext_vector_type(8)));
typedef short bf16x4 __attribute__((ext_vector_type(4)));
typedef unsigned u32x4 __attribute__((ext_vector_type(4)));
typedef unsigned u32x2 __attribute__((ext_vector_type(2)));

__device__ __forceinline__ float bf2f(unsigned short b) { return __uint_as_float(((unsigned)b) << 16); }
__device__ __forceinline__ float fast_sigmoid(float x) { return __builtin_amdgcn_rcpf(1.0f + __expf(-x)); }

template <int CTRL> __device__ __forceinline__ float dpp_mov(float v) {
    return __builtin_bit_cast(float, __builtin_amdgcn_update_dpp(0, __builtin_bit_cast(int, v), CTRL, 0xF, 0xF, true));
}
__device__ __forceinline__ float wave_sum(float v) {
    v += dpp_mov<0xB1>(v);
    v += dpp_mov<0x4E>(v);
    v += dpp_mov<0x141>(v);
    v += dpp_mov<0x140>(v);
    v += __shfl_xor(v, 16);
    v += __shfl_xor(v, 32);
    return v;
}

struct Args { const float* in[27]; float* out; unsigned char* ws; int ph_lo, ph_hi; };

namespace pg8 {
struct EpiSwiGLU {
    static constexpr bool PERM = true, AFTER_DRAIN = false;
    bf16_t* O; int ldc; const float* ss;
    struct Pre { float v[8]; };
    __device__ __forceinline__ void prefetch(const Unit& u, int wr, int wc, int fr, int fq, Pre& p) const {
        const int row0 = u.pm * BM + wr * 64 + fr;
#pragma unroll
        for (int i = 0; i < 8; ++i) p.v[i] = ss[row0 + (i >> 2) * HALF + (i & 3) * 16];
    }
    __device__ __forceinline__ void operator()(const f32x4 (&acc)[2][2][4][2], const Unit& u, int wr, int wc, int fr, int fq, const Pre& pre) const {
        const int row0 = u.pm * BM + wr * 64 + fr, col0 = u.pn * 128 + wc * 32 + 8 * fq;
#pragma unroll
        for (int ai = 0; ai < 2; ++ai)
#pragma unroll
            for (int m = 0; m < 4; ++m) {
                const int row = row0 + ai * HALF + m * 16;
                const float rs = __builtin_amdgcn_rsqf(pre.v[ai * 4 + m] * (1.0f / 1024.0f) + 1e-6f);
                float h[8];
#pragma unroll
                for (int n = 0; n < 2; ++n)
#pragma unroll
                    for (int j = 0; j < 4; ++j) { const float g = acc[ai][0][m][n][j] * rs, up = acc[ai][1][m][n][j] * rs; h[4 * n + j] = g * up * __builtin_amdgcn_rcpf(1.0f + __expf(-g)); }
                u32x4 w; w.x = cvt_pk_bf16(h[0], h[1]); w.y = cvt_pk_bf16(h[2], h[3]); w.z = cvt_pk_bf16(h[4], h[5]); w.w = cvt_pk_bf16(h[6], h[7]);
                *(u32x4*)(O + (size_t)row * ldc + col0) = w;
            }
    }
};
struct EpiResid {
    static constexpr bool PERM = true, AFTER_DRAIN = false;
    bf16_t* XB; float* ss; float scale;
    struct Pre { };
    __device__ __forceinline__ void prefetch(const Unit&, int, int, int, int, Pre&) const {}
    __device__ __forceinline__ void operator()(const f32x4 (&acc)[2][2][4][2], const Unit& u, int wr, int wc, int fr, int fq, const Pre&) const {
        const int row0 = u.pm * BM + wr * 64 + fr, col0 = u.pn * BM + wc * 32 + 8 * fq;
#pragma unroll
        for (int ai = 0; ai < 2; ++ai)
#pragma unroll
            for (int m = 0; m < 4; ++m) {
                const int row = row0 + ai * HALF + m * 16; bf16_t* p = XB + (size_t)row * 1024 + col0; float q = 0.f;
                const u32x4 r0 = *(const u32x4*)p, r1 = *(const u32x4*)(p + HALF);
#pragma unroll
                for (int bj = 0; bj < 2; ++bj) {
                    const u32x4 rv = bj ? r1 : r0; float v[8];
#pragma unroll
                    for (int e = 0; e < 8; ++e) { const unsigned wd = rv[e >> 1]; const float x = __uint_as_float((e & 1) ? (wd & 0xffff0000u) : (wd << 16));
                        v[e] = fmaf(acc[ai][bj][m][e >> 2][e & 3], scale, x); q = fmaf(v[e], v[e], q); }
                    u32x4 w; w.x = cvt_pk_bf16(v[0], v[1]); w.y = cvt_pk_bf16(v[2], v[3]); w.z = cvt_pk_bf16(v[4], v[5]); w.w = cvt_pk_bf16(v[6], v[7]);
                    *(u32x4*)(p + bj * HALF) = w;
                }
                q += __shfl_xor(q, 16); q += __shfl_xor(q, 32);
                if (fq == 0) atomicAdd(ss + row, q);
            }
    }
};
struct EpiWin {
    static constexpr bool PERM = true, AFTER_DRAIN = false;
    bf16_t* U; bf16_t* Z; const float* ss;
    struct Pre { float v[8]; };
    __device__ __forceinline__ void prefetch(const Unit& u, int wr, int wc, int fr, int fq, Pre& p) const {
        const int row0 = u.pm * BM + wr * 64 + fr;
#pragma unroll
        for (int i = 0; i < 8; ++i) p.v[i] = ss[row0 + (i >> 2) * HALF + (i & 3) * 16];
    }
    __device__ __forceinline__ void operator()(const f32x4 (&acc)[2][2][4][2], const Unit& u, int wr, int wc, int fr, int fq, const Pre& pre) const {
        const int row0 = u.pm * BM + wr * 64 + fr, cw = wc * 32 + 8 * fq;
#pragma unroll
        for (int ai = 0; ai < 2; ++ai)
#pragma unroll
            for (int m = 0; m < 4; ++m) {
                const int row = row0 + ai * HALF + m * 16;
                const float rs = __builtin_amdgcn_rsqf(pre.v[ai * 4 + m] * (1.0f / 1024.0f) + 1e-6f);
                if (u.pn < 2) {
#pragma unroll
                    for (int bj = 0; bj < 2; ++bj) { const f32x4 v0 = acc[ai][bj][m][0] * rs, v1 = acc[ai][bj][m][1] * rs;
                        u32x4 w; w.x = cvt_pk_bf16(v0[0], v0[1]); w.y = cvt_pk_bf16(v0[2], v0[3]); w.z = cvt_pk_bf16(v1[0], v1[1]); w.w = cvt_pk_bf16(v1[2], v1[3]);
                        *(u32x4*)(U + (size_t)row * 512 + u.pn * 256 + bj * HALF + cw) = w; }
                } else {
                    float h[8];
#pragma unroll
                    for (int n = 0; n < 2; ++n)
#pragma unroll
                        for (int j = 0; j < 4; ++j) { const float a = acc[ai][0][m][n][j] * rs, g = acc[ai][1][m][n][j] * rs; h[4 * n + j] = a * __builtin_amdgcn_rcpf(1.0f + __expf(-g)); }
                    u32x4 w; w.x = cvt_pk_bf16(h[0], h[1]); w.y = cvt_pk_bf16(h[2], h[3]); w.z = cvt_pk_bf16(h[4], h[5]); w.w = cvt_pk_bf16(h[6], h[7]);
                    *(u32x4*)(Z + (size_t)row * 512 + (u.pn - 2) * 128 + cw) = w;
                }
            }
    }
};
struct EpiGlu {
    static constexpr bool PERM = true, AFTER_DRAIN = false;
    const bf16_t* YS; bf16_t* YM; const float* bias;
    struct Pre { };
    __device__ __forceinline__ void prefetch(const Unit&, int, int, int, int, Pre&) const {}
    __device__ __forceinline__ void operator()(const f32x4 (&acc)[2][2][4][2], const Unit& u, int wr, int wc, int fr, int fq, const Pre&) const {
        const int row0 = u.pm * BM + wr * 64 + fr, col0 = u.pn * BM + wc * 32 + 8 * fq;
        f32x4 bv[2][2];
#pragma unroll
        for (int bj = 0; bj < 2; ++bj)
#pragma unroll
            for (int n = 0; n < 2; ++n) bv[bj][n] = *(const f32x4*)(bias + col0 + bj * HALF + 4 * n);
#pragma unroll
        for (int ai = 0; ai < 2; ++ai)
#pragma unroll
            for (int m = 0; m < 4; ++m) {
                const int row = row0 + ai * HALF + m * 16;
#pragma unroll
                for (int bj = 0; bj < 2; ++bj) {
                    const u32x4 yv = *(const u32x4*)(YS + (size_t)row * 512 + col0 + bj * HALF);
                    float h[8];
#pragma unroll
                    for (int n = 0; n < 2; ++n)
#pragma unroll
                        for (int j = 0; j < 4; ++j) { const int e = 4 * n + j; const unsigned wd = yv[e >> 1]; const float y = __uint_as_float((e & 1) ? (wd & 0xffff0000u) : (wd << 16));
                            const float g = acc[ai][bj][m][n][j] + bv[bj][n][j]; h[e] = y * __builtin_amdgcn_rcpf(1.0f + __expf(-g)); }
                    u32x4 w; w.x = cvt_pk_bf16(h[0], h[1]); w.y = cvt_pk_bf16(h[2], h[3]); w.z = cvt_pk_bf16(h[4], h[5]); w.w = cvt_pk_bf16(h[6], h[7]);
                    *(u32x4*)(YM + (size_t)row * 1024 + col0 + bj * HALF) = w;
                }
            }
    }
};
}

__device__ __forceinline__ unsigned f2bf(float f) { unsigned u = __float_as_uint(f); return (u + 0x7fffu + ((u >> 16) & 1u)) >> 16; }
__device__ __forceinline__ unsigned pk2(float lo, float hi) { return f2bf(lo) | (f2bf(hi) << 16); }

__device__ __forceinline__ int rowmap(int mode, int n0) {
    if (mode == 1) return 256 * (n0 >> 7) + (n0 & 127);
    if (mode == 2) return 256 * (n0 >> 7) + 128 + (n0 & 127);
    if (mode == 3) { if (n0 < 512) return n0; if (n0 < 1024) { const int j = n0 - 512; return 512 + 256 * (j >> 7) + (j & 127); } const int j = n0 - 1024; return 512 + 256 * (j >> 7) + 128 + (j & 127); }
    return n0;
}
__device__ __forceinline__ void transpose_item(const float* W, int K, int N, const float* gain, bf16* WT, int mode, LAS float* scr, int item, int lane) {
    const int nblk = N / 32, kb = item / nblk, nb = item % nblk, k0 = 64 * kb, n0 = 32 * nb;
    float wv[32];
#pragma unroll
    for (int i = 0; i < 32; ++i) { const int kk = 2 * i + (lane >> 5); wv[i] = __builtin_nontemporal_load(&W[(size_t)(k0 + kk) * N + n0 + (lane & 31)]); }
    if (gain) {
#pragma unroll
        for (int i = 0; i < 32; ++i) wv[i] *= gain[k0 + 2 * i + (lane >> 5)]; }
#pragma unroll
    for (int i = 0; i < 32; ++i) scr[(2 * i + (lane >> 5)) * 33 + (lane & 31)] = wv[i];
    asm volatile("s_waitcnt lgkmcnt(0)" ::: "memory");
    const int c = lane & 7, d0 = rowmap(mode, n0);
#pragma unroll
    for (int j = 0; j < 4; ++j) { const int n = (lane >> 3) + 8 * j; const LAS float* s = scr + (8 * c) * 33 + n;
        u32x4 o; o.x = pg8::cvt_pk_bf16(s[0 * 33], s[1 * 33]); o.y = pg8::cvt_pk_bf16(s[2 * 33], s[3 * 33]); o.z = pg8::cvt_pk_bf16(s[4 * 33], s[5 * 33]); o.w = pg8::cvt_pk_bf16(s[6 * 33], s[7 * 33]);
        *(u32x4*)(WT + (size_t)(d0 + n) * K + k0 + 8 * c) = o; }
    asm volatile("s_waitcnt lgkmcnt(0)" ::: "memory");
}

__device__ __forceinline__ void my_sincos(float x, float& s, float& c) {
    const float q = rintf(x * 0.636619772367581f);
    float r = fmaf(-q, 1.5703125f, x); r = fmaf(-q, 4.837512969970703e-4f, r); r = fmaf(-q, 7.549789954891882e-8f, r);
    const float z = r * r;
    const float sp = r + r * z * (-1.6666654611e-1f + z * (8.3321608736e-3f + z * (-1.9515295891e-4f)));
    const float cp = 1.0f - 0.5f * z + z * z * (4.166664568298827e-2f + z * (-1.388731625493765e-3f + z * 2.443315711809948e-5f));
    const int qi = ((int)q) & 3;
    s = (qi == 0) ? sp : (qi == 1) ? cp : (qi == 2) ? -sp : -cp;
    c = (qi == 0) ? cp : (qi == 1) ? -sp : (qi == 2) ? -cp : sp;
}
__device__ __forceinline__ void s5_coeffs(const Args& A, int g, int p, float& ar, float& ai, float& fre, float& fim) {
    const float lr = A.in[7][g * NP + p], li = A.in[8][g * NP + p], dt = expf(A.in[9][g]);
    const float mag = expf(lr * dt); float s, c; my_sincos(li * dt, s, c); ar = mag * c; ai = mag * s;
    const float den = lr * lr + li * li, nr = ar - 1.0f, ni = ai;
    fre = (nr * lr + ni * li) / den; fim = (ni * lr - nr * li) / den;
}

__device__ __forceinline__ void prologue(LAS unsigned char* lds, const Args& A, int G) {
    const int tid = threadIdx.x, lane = tid & 63, wave = __builtin_amdgcn_readfirstlane(tid >> 6);
    unsigned char* ws = A.ws;
    LAS float* scr = (LAS float*)(lds + wave * 16384);
    const int gw = blockIdx.x * NWAVES + wave, NGW = G * NWAVES;
    constexpr int I_GU = (DM / 64) * (DFF / 32), I_DN = (DFF / 64) * (DM / 32), I_IN = (DM / 64) * (NIN / 32), I_GL = (S5W / 64) * (S5W / 32), I_OUT = (DM / 64) * (DM / 32);
    constexpr int NITEMS = 4 * I_GU + 2 * I_DN + I_IN + I_GL + I_OUT;
    for (int it = gw; it < NITEMS; it += NGW) {
        int r = it;
        if (r < I_GU) { transpose_item(A.in[2], DM, DFF, A.in[1], (bf16*)(ws + WS_W1GU), 1, scr, r, lane); continue; } r -= I_GU;
        if (r < I_GU) { transpose_item(A.in[3], DM, DFF, A.in[1], (bf16*)(ws + WS_W1GU), 2, scr, r, lane); continue; } r -= I_GU;
        if (r < I_DN) { transpose_item(A.in[4], DFF, DM, nullptr, (bf16*)(ws + WS_W1D), 0, scr, r, lane); continue; } r -= I_DN;
        if (r < I_IN) { transpose_item(A.in[6], DM, NIN, A.in[5], (bf16*)(ws + WS_WIN), 3, scr, r, lane); continue; } r -= I_IN;
        if (r < I_GL) { transpose_item(A.in[15], S5W, S5W, nullptr, (bf16*)(ws + WS_WGLU), 0, scr, r, lane); continue; } r -= I_GL;
        if (r < I_OUT) { transpose_item(A.in[21], DM, DM, nullptr, (bf16*)(ws + WS_WOUT), 0, scr, r, lane); continue; } r -= I_OUT;
        if (r < I_GU) { transpose_item(A.in[23], DM, DFF, A.in[22], (bf16*)(ws + WS_W2GU), 1, scr, r, lane); continue; } r -= I_GU;
        if (r < I_GU) { transpose_item(A.in[24], DM, DFF, A.in[22], (bf16*)(ws + WS_W2GU), 2, scr, r, lane); continue; } r -= I_GU;
        transpose_item(A.in[25], DFF, DM, nullptr, (bf16*)(ws + WS_W2D), 0, scr, r, lane);
    }
    float* ss = (float*)(ws + WS_SS);
    bf16* XB = (bf16*)(ws + WS_XB);
    for (int row = 4 * gw; row < MTOK; row += 4 * NGW) {
        f32x4 v[4][4];
#pragma unroll
        for (int r = 0; r < 4; ++r) { const f32x4* xr = (const f32x4*)(A.in[0] + (size_t)(row + r) * DM) + lane;
#pragma unroll
            for (int j = 0; j < 4; ++j) v[r][j] = __builtin_nontemporal_load(&xr[64 * j]); }
#pragma unroll
        for (int r = 0; r < 4; ++r) { float sq = 0.f;
#pragma unroll
            for (int j = 0; j < 4; ++j) sq += (v[r][j][0] * v[r][j][0] + v[r][j][1] * v[r][j][1]) + (v[r][j][2] * v[r][j][2] + v[r][j][3] * v[r][j][3]);
            sq = wave_sum(sq);
            if (lane == 0) ss[row + r] = sq;
            u32x2* o = (u32x2*)(XB + (size_t)(row + r) * DM) + lane;
#pragma unroll
            for (int j = 0; j < 4; ++j) { u32x2 w; w.x = pg8::cvt_pk_bf16(v[r][j][0], v[r][j][1]); w.y = pg8::cvt_pk_bf16(v[r][j][2], v[r][j][3]); o[64 * j] = w; } }
    }
    const int gt = blockIdx.x * (NWAVES * 64) + tid, NT = G * NWAVES * 64;
    for (int i = gt; i < 3 * MTOK; i += NT) ss[MTOK + i] = 0.f;
    f32x2* abar = (f32x2*)(ws + WS_S5A); f32x2* abarT = (f32x2*)(ws + WS_S5AT);
    u32x4* bfrag = (u32x4*)(ws + WS_S5BF); u32x4* cfrag = (u32x4*)(ws + WS_S5CF);
    for (int i = gt; i < NG * NP; i += NT) {
        const int g = i / NP, p = i % NP; float ar, ai, fre, fim; s5_coeffs(A, g, p, ar, ai, fre, fim);
        abar[i] = (f32x2){ar, ai};
        float tr = ar, ti = ai;
#pragma unroll
        for (int k = 0; k < 5; ++k) { const float nr = tr * tr - ti * ti, ni = 2.0f * tr * ti; tr = nr; ti = ni; }
        abarT[i] = (f32x2){tr, ti};
    }
    for (int i = gt; i < NG * 8 * 64; i += NT) {
        const int ln = i & 63, nt = (i >> 6) & 7, g = i >> 9, p = 16 * (nt & 3) + (ln & 15), c0 = 8 * (ln >> 4);
        u32x4 o = (u32x4){0u, 0u, 0u, 0u};
        if (c0 < 16) {
            float ar, ai, fre, fim; s5_coeffs(A, g, p, ar, ai, fre, fim);
            const float* br = A.in[10] + ((size_t)g * NP + p) * NC + c0; const float* bi = A.in[11] + ((size_t)g * NP + p) * NC + c0;
            float v[8];
#pragma unroll
            for (int k = 0; k < 8; ++k) v[k] = (nt < 4) ? (fre * br[k] - fim * bi[k]) : (fre * bi[k] + fim * br[k]);
            o.x = pk2(v[0], v[1]); o.y = pk2(v[2], v[3]); o.z = pk2(v[4], v[5]); o.w = pk2(v[6], v[7]);
        }
        bfrag[i] = o;
    }
    for (int i = gt; i < NG * 4 * 64; i += NT) {
        const int ln = i & 63, ks = (i >> 6) & 3, g = i >> 8, c = ln & 15, p0 = 16 * ks + 4 * (ln >> 4);
        const float* cr = A.in[12] + ((size_t)g * NC + c) * NP + p0; const float* ci = A.in[13] + ((size_t)g * NC + c) * NP + p0;
        u32x4 o; o.x = pk2(cr[0], -ci[0]); o.y = pk2(cr[1], -ci[1]); o.z = pk2(cr[2], -ci[2]); o.w = pk2(cr[3], -ci[3]);
        cfrag[i] = o;
    }
}

constexpr int XS_PITCH = 68;
constexpr int XS_WAVE_BYTES = 32 * XS_PITCH * 4;
constexpr int CARRY_OFF = NWAVES * XS_WAVE_BYTES;
__device__ __forceinline__ void s5_phase(LAS unsigned char* lds, const Args& A, int G) {
    const int tid = threadIdx.x, lane = tid & 63, w = __builtin_amdgcn_readfirstlane(tid >> 6), fr = lane & 15, fq = lane >> 4;
    unsigned char* ws = A.ws;
    LAS unsigned* xs = (LAS unsigned*)(lds + w * XS_WAVE_BYTES);
    LAS f32x2* carry = (LAS f32x2*)(lds + CARRY_OFF);
    const f32x2* abar = (const f32x2*)(ws + WS_S5A); const f32x2* abarT = (const f32x2*)(ws + WS_S5AT);
    const bf16x8* bfrag = (const bf16x8*)(ws + WS_S5BF); const bf16x8* cfrag = (const bf16x8*)(ws + WS_S5CF);
    const bf16* U = (const bf16*)(ws + WS_U); bf16* YS = (bf16*)(ws + WS_YS);
    for (int item = blockIdx.x; item < BATCH * NG; item += G) {
        const int b = item & (BATCH - 1), g = (item >> 3) & (NG - 1);
        const f32x2 a = abar[g * NP + lane], aT = abarT[g * NP + lane];
        bf16x8 bfr[8], cfr[4];
#pragma unroll
        for (int nt = 0; nt < 8; ++nt) bfr[nt] = bfrag[(g * 8 + nt) * 64 + lane];
#pragma unroll
        for (int ks = 0; ks < 4; ++ks) cfr[ks] = cfrag[(g * 4 + ks) * 64 + lane];
        const f32x4 dsk = *(const f32x4*)(A.in[14] + g * NC + 4 * fq);
        const bf16* Ub = U + (size_t)b * SEQ * S5W + g * NC;
        bf16* Yb = YS + (size_t)b * SEQ * S5W + g * NC;
        float xr = 0.f, xi = 0.f;
        bf16x8 uf[2]; u32x2 usk[2];
#pragma unroll
        for (int mt = 0; mt < 2; ++mt) { const size_t t = (size_t)(32 * w + 16 * mt + fr);
            uf[mt] = (bf16x8){0, 0, 0, 0, 0, 0, 0, 0}; if (fq < 2) uf[mt] = *(const bf16x8*)(Ub + t * S5W + 8 * fq);
            usk[mt] = *(const u32x2*)(Ub + t * S5W + 4 * fq); }
        for (int sc = 0; sc < 16; ++sc) {
            const int tb = sc * 256 + 32 * w;
#pragma unroll
            for (int mt = 0; mt < 2; ++mt)
#pragma unroll
                for (int nt = 0; nt < 4; ++nt) {
                    const f32x4 z4 = (f32x4){0.f, 0.f, 0.f, 0.f};
                    const f32x4 dre = __builtin_amdgcn_mfma_f32_16x16x32_bf16(bfr[nt], uf[mt], z4, 0, 0, 0);
                    const f32x4 dim = __builtin_amdgcn_mfma_f32_16x16x32_bf16(bfr[4 + nt], uf[mt], z4, 0, 0, 0);
                    u32x4 wv; wv.x = pg8::cvt_pk_bf16(dre[0], dim[0]); wv.y = pg8::cvt_pk_bf16(dre[1], dim[1]); wv.z = pg8::cvt_pk_bf16(dre[2], dim[2]); wv.w = pg8::cvt_pk_bf16(dre[3], dim[3]);
                    *(LAS u32x4*)(xs + (16 * mt + fr) * XS_PITCH + 16 * nt + 4 * fq) = wv;
                }
            const u32x2 usk_cur0 = usk[0], usk_cur1 = usk[1];
            if (sc + 1 < 16) {
#pragma unroll
                for (int mt = 0; mt < 2; ++mt) { const size_t t = (size_t)(tb + 256 + 16 * mt + fr);
                    if (fq < 2) uf[mt] = *(const bf16x8*)(Ub + t * S5W + 8 * fq);
                    usk[mt] = *(const u32x2*)(Ub + t * S5W + 4 * fq); }
            }
            unsigned v[32];
#pragma unroll
            for (int t = 0; t < 32; ++t) v[t] = xs[t * XS_PITCH + lane];
            float sr = 0.f, si = 0.f;
#pragma unroll
            for (int t = 0; t < 32; ++t) { const float br = __uint_as_float(v[t] << 16), bi = __uint_as_float(v[t] & 0xffff0000u);
                const float nr = fmaf(-a.y, si, fmaf(a.x, sr, br)), ni = fmaf(a.y, sr, fmaf(a.x, si, bi)); sr = nr; si = ni; }
            carry[(sc & 1) * 512 + w * 64 + lane] = (f32x2){sr, si};
            __syncthreads();
            float cr = xr, ci = xi, mr = 0.f, mi = 0.f;
#pragma unroll
            for (int vv = 0; vv < 8; ++vv) { if (vv == w) { mr = cr; mi = ci; }
                const f32x2 e = carry[(sc & 1) * 512 + vv * 64 + lane];
                const float nr = fmaf(-aT.y, ci, fmaf(aT.x, cr, e.x)), ni = fmaf(aT.y, cr, fmaf(aT.x, ci, e.y)); cr = nr; ci = ni; }
            xr = cr; xi = ci;
            sr = mr; si = mi;
#pragma unroll
            for (int t = 0; t < 32; ++t) { const float br = __uint_as_float(v[t] << 16), bi = __uint_as_float(v[t] & 0xffff0000u);
                const float nr = fmaf(-a.y, si, fmaf(a.x, sr, br)), ni = fmaf(a.y, sr, fmaf(a.x, si, bi)); sr = nr; si = ni;
                xs[t * XS_PITCH + lane] = pg8::cvt_pk_bf16(sr, si); }
#pragma unroll
            for (int mt = 0; mt < 2; ++mt) {
                f32x4 d = (f32x4){0.f, 0.f, 0.f, 0.f};
#pragma unroll
                for (int ks = 0; ks < 4; ++ks) { const bf16x8 xf = *(const LAS bf16x8*)(xs + (16 * mt + fr) * XS_PITCH + 16 * ks + 4 * fq);
                    d = __builtin_amdgcn_mfma_f32_16x16x32_bf16(cfr[ks], xf, d, 0, 0, 0); }
                const u32x2 uu = mt ? usk_cur1 : usk_cur0;
                float y[4];
#pragma unroll
                for (int j = 0; j < 4; ++j) { const unsigned wd = uu[j >> 1]; const float uval = __uint_as_float((j & 1) ? (wd & 0xffff0000u) : (wd << 16));
                    const float yy = d[j] + dsk[j] * uval; const float zz = 1.5957691216f * (yy + 0.044715f * yy * yy * yy);
                    y[j] = yy * __builtin_amdgcn_rcpf(1.0f + __expf(-zz)); }
                u32x2 o; o.x = pg8::cvt_pk_bf16(y[0], y[1]); o.y = pg8::cvt_pk_bf16(y[2], y[3]);
                __builtin_nontemporal_store(o, (u32x2*)(Yb + (size_t)(tb + 16 * mt + fr) * S5W + 4 * fq));
            }
        }
    }
    __syncthreads();
}

__device__ __forceinline__ float half_sum(float v) {
    v += dpp_mov<0xB1>(v); v += dpp_mov<0x4E>(v); v += dpp_mov<0x141>(v); v += dpp_mov<0x140>(v);
    v += __shfl_xor(v, 16);
    return v;
}
__device__ __forceinline__ void conv_phase(const Args& A, int G) {
    const int tid = threadIdx.x, lane = tid & 63, wave = __builtin_amdgcn_readfirstlane(tid >> 6);
    unsigned char* ws = A.ws;
    const bf16* Z = (const bf16*)(ws + WS_Z); bf16* YM = (bf16*)(ws + WS_YM);
    const int gw = blockIdx.x * NWAVES + wave, NGW = G * NWAVES;
    constexpr int TT = 16, NTILE = 4, SEGT = TT * NTILE;
    for (int item = gw; item < BATCH * 4 * (SEQ / SEGT); item += NGW) {
        const int blk = item >> 3, wv_ = item & 7, b = blk & (BATCH - 1), idx = ((blk >> 3) << 3) + wv_;
        const int seg = idx & (SEQ / SEGT - 1), hp = (idx >> 6) & 3, ch0 = hp * 128 + 2 * lane;
        f32x2 wk[CK];
#pragma unroll
        for (int k = 0; k < CK; ++k) wk[k] = *(const f32x2*)(A.in[17] + k * CVW + ch0);
        const f32x2 bias = *(const f32x2*)(A.in[18] + ch0), lg = *(const f32x2*)(A.in[19] + ch0), lb = *(const f32x2*)(A.in[20] + ch0);
        const bf16* zp = Z + (size_t)b * SEQ * CVW + hp * 128;
        bf16* op = YM + (size_t)b * SEQ * DM + 512 + hp * 128;
        const int t0 = seg * SEGT;
        f32x2 wp[30 + TT];
#pragma unroll
        for (int i = 0; i < 30; ++i) wp[i] = (f32x2){0.f, 0.f};
        if (t0 > 0) {
#pragma unroll
            for (int i = 0; i < 30; ++i) { const unsigned wv = __builtin_nontemporal_load(&((const unsigned*)(zp + (size_t)(t0 - 30 + i) * CVW))[lane]);
                wp[i] = (f32x2){__uint_as_float(wv << 16), __uint_as_float(wv & 0xffff0000u)}; }
        }
#pragma unroll 1
        for (int tt = 0; tt < NTILE; ++tt) {
            const int tb = t0 + TT * tt;
#pragma unroll
            for (int i = 0; i < TT; ++i) { const unsigned wv = __builtin_nontemporal_load(&((const unsigned*)(zp + (size_t)(tb + i) * CVW))[lane]);
                wp[30 + i] = (f32x2){__uint_as_float(wv << 16), __uint_as_float(wv & 0xffff0000u)}; }
#pragma unroll
            for (int i = 0; i < TT; ++i) {
                f32x2 acc = bias;
#pragma unroll
                for (int k = 0; k < CK; ++k) acc = __builtin_elementwise_fma(wk[k], wp[i + k], acc);
                const float s1 = half_sum(acc.x + acc.y), s2 = half_sum(fmaf(acc.x, acc.x, acc.y * acc.y));
                const float mean = s1 * (1.0f / 64.0f);
                const float var = fmaxf(s2 * (1.0f / 64.0f) - mean * mean, 0.0f);
                const float rstd = __builtin_amdgcn_rsqf(var + EPS);
                const f32x2 zn = (acc - mean) * rstd * lg + lb;
                f32x2 y; y.x = zn.x * __builtin_amdgcn_rcpf(1.0f + __expf(-zn.x)); y.y = zn.y * __builtin_amdgcn_rcpf(1.0f + __expf(-zn.y));
                __builtin_nontemporal_store(pg8::cvt_pk_bf16(y.x, y.y), &((unsigned*)(op + (size_t)(tb + i) * DM))[lane]);
            }
#pragma unroll
            for (int i = 0; i < 30; ++i) wp[i] = wp[TT + i];
        }
    }
}

__device__ __forceinline__ void final_phase(const Args& A, int G, int ssi = 3) {
    const int tid = threadIdx.x, lane = tid & 63, wave = __builtin_amdgcn_readfirstlane(tid >> 6);
    const float* ss4 = (const float*)(A.ws + WS_SS) + ssi * MTOK;
    const int gw = blockIdx.x * NWAVES + wave, NGW = G * NWAVES;
    f32x4 gv[4];
#pragma unroll
    for (int j = 0; j < 4; ++j) gv[j] = ((const f32x4*)A.in[26])[64 * j + lane];
    const bf16* XBf = (const bf16*)(A.ws + WS_XB);
    const bool xmap = (G == 256);
    const int xq = blockIdx.x & 7, jq = (blockIdx.x >> 3) * NWAVES + wave;
    for (int it = 0; it < (xmap ? 4 : 0x7fffffff); ++it) {
        const int row = xmap ? (4096 * xq + 1024 * it + 4 * jq) : (4 * gw + it * 4 * NGW);
        if (row >= MTOK) break;
        u32x2 w[4][4]; float rs[4];
#pragma unroll
        for (int r = 0; r < 4; ++r) { const u32x2* xi = (const u32x2*)(XBf + (size_t)(row + r) * DM) + lane; rs[r] = ss4[row + r];
#pragma unroll
            for (int j = 0; j < 4; ++j) w[r][j] = __builtin_nontemporal_load(&xi[64 * j]); }
#pragma unroll
        for (int r = 0; r < 4; ++r) { const float rr = __builtin_amdgcn_rsqf(rs[r] * (1.0f / 1024.0f) + EPS);
            f32x4* o = (f32x4*)(A.out + (size_t)(row + r) * DM) + lane;
#pragma unroll
            for (int j = 0; j < 4; ++j) { const u32x2 ww = w[r][j];
                const f32x4 v = (f32x4){__uint_as_float(ww.x << 16), __uint_as_float(ww.x & 0xffff0000u), __uint_as_float(ww.y << 16), __uint_as_float(ww.y & 0xffff0000u)};
                __builtin_nontemporal_store(v * rr * gv[j], &o[64 * j]); } }
    }
}


#define GAS __attribute__((address_space(1)))
constexpr size_t WS_CTL = 0, CTL_ZERO_BYTES = 65536;
constexpr int MISC_OFF = 131072 + 320;
#define XB_TMO      128
#define XB_XCNT(j)  (256  + 64 * (j))
#define XB_XSUB(j)  (1280 + 64 * (j))
#define XB_XGEN(j)  (2304 + 64 * (j))
#define XB_TOP      3328
#define XB_TOPGEN   3392
#define XCD_BAR_WORDS 3456
#define XB_SPIN_CAP (1u << 18)

__device__ __forceinline__ unsigned xb_ld(unsigned* p)              { return __hip_atomic_load(p, __ATOMIC_RELAXED, __HIP_MEMORY_SCOPE_AGENT); }
__device__ __forceinline__ unsigned xb_add(unsigned* p, unsigned v) { return __hip_atomic_fetch_add(p, v, __ATOMIC_RELAXED, __HIP_MEMORY_SCOPE_AGENT); }
__device__ __forceinline__ unsigned xb_xcc_id() { return (unsigned)__builtin_amdgcn_s_getreg((3 << 11) | 20) & 0xFu; }
#define XB_SPIN(cond, bar) do { unsigned _sp = 0; while (cond) { __builtin_amdgcn_s_sleep(1); \
    if ((++_sp & 255u) == 0u) { if (xb_ld(&(bar)[XB_TMO])) break; if (_sp > XB_SPIN_CAP) { atomicAdd(&(bar)[XB_TMO], 1u); break; } } } } while (0)

struct XcdBarrier {
    unsigned* bar; unsigned x;
    volatile LAS unsigned* st;
};

__device__ __forceinline__ XcdBarrier xcd_barrier_post(unsigned* bar, volatile LAS unsigned* st) {
    XcdBarrier b; b.bar = bar; b.x = xb_xcc_id(); b.st = st;
    if (threadIdx.x == 0) (void)xb_add(&bar[XB_XCNT(b.x)], 1u);
    return b;
}
__device__ __forceinline__ void xcd_barrier_complete(unsigned* bar, unsigned x, unsigned& nloc, unsigned& nx) {
    const unsigned G = gridDim.x * gridDim.y * gridDim.z;
    unsigned sum, cnt, mine, sp = 0u;
    for (;;) {
        sum = 0u; cnt = 0u; mine = 0u;
#pragma unroll
        for (unsigned j = 0; j < 16; ++j) { const unsigned c = xb_ld(&bar[XB_XCNT(j)]); sum += c; cnt += (c > 0u) ? 1u : 0u; mine = (j == x) ? c : mine; }
        if (sum == G) break;
        __builtin_amdgcn_s_sleep(1);
        if ((++sp & 255u) == 0u) { if (xb_ld(&bar[XB_TMO])) break; if (sp > XB_SPIN_CAP) { atomicAdd(&bar[XB_TMO], 1u); break; } }
    }
    nloc = mine > 0u ? mine : 1u; nx = cnt > 0u ? cnt : 1u;
}

__device__ __forceinline__ void xcd_barrier(const XcdBarrier& b) {
    asm volatile("s_waitcnt vmcnt(0)" ::: "memory");
    __syncthreads();
    if (threadIdx.x == 0) {
        unsigned* bar = b.bar;
        __builtin_amdgcn_s_waitcnt(0);
        unsigned nloc = b.st[0], nx = b.st[1];
        if (nloc == 0u) { xcd_barrier_complete(bar, b.x, nloc, nx); b.st[0] = nloc; b.st[1] = nx; }
        const unsigned old = xb_add(&bar[XB_XSUB(b.x)], 1u);
        const unsigned gen = old / nloc;
        if (old + 1u == (gen + 1u) * nloc) {
            __builtin_amdgcn_fence(__ATOMIC_RELEASE, "agent");
            asm volatile("s_waitcnt vmcnt(0)" ::: "memory");
            const unsigned og = xb_add(&bar[XB_TOP], 1u);
            const unsigned tg = og / nx;
            if (og + 1u == (tg + 1u) * nx) xb_add(&bar[XB_TOPGEN], 1u);
            else XB_SPIN(xb_ld(&bar[XB_TOPGEN]) == tg, bar);
            __builtin_amdgcn_fence(__ATOMIC_ACQUIRE, "agent");
            xb_add(&bar[XB_XGEN(b.x)], 1u);
            asm volatile("s_waitcnt vmcnt(0)" ::: "memory");
        } else {
            XB_SPIN(xb_ld(&bar[XB_XGEN(b.x)]) == gen, bar);
            __builtin_amdgcn_fence(__ATOMIC_ACQUIRE, "agent");
            asm volatile("s_waitcnt vmcnt(0)" ::: "memory");
        }
    }
    __syncthreads();
}

#define LB_MASK(j) (4096 + 64 * (j))
#define LB_SUB(j)  (5120 + 64 * (j))
#define LB_GEN(j)  (6144 + 64 * (j))
__device__ __forceinline__ void xcc_local_barrier(const XcdBarrier& b) {
    asm volatile("s_waitcnt vmcnt(0)" ::: "memory");
    __syncthreads();
    if (threadIdx.x == 0) {
        unsigned* bar = b.bar;
        __builtin_amdgcn_s_waitcnt(0);
        const unsigned old = xb_add(&bar[LB_SUB(b.x)], 1u);
        const unsigned gen = old / 32u;
        if (old + 1u == (gen + 1u) * 32u) xb_add(&bar[LB_GEN(b.x)], 1u);
        else XB_SPIN(xb_ld(&bar[LB_GEN(b.x)]) == gen, bar);
        __builtin_amdgcn_fence(__ATOMIC_ACQUIRE, "agent");
        asm volatile("s_waitcnt vmcnt(0)" ::: "memory");
    }
    __syncthreads();
}

__device__ __forceinline__ void dbg_dump(const Args& A, int G, const bf16* a, int lda, const bf16* b, int ldb) {
    const int gt = blockIdx.x * (NWAVES * 64) + threadIdx.x, NT = G * NWAVES * 64;
    for (size_t i = gt; i < (size_t)MTOK * DM; i += NT) { const size_t row = i >> 10; const int c = (int)(i & 1023);
        A.out[i] = (c < 512) ? bf2f(a[row * lda + c]) : bf2f(b[row * ldb + (c - 512)]); }
}
constexpr int N_PHASES = 10;
__global__ void __launch_bounds__(NWAVES * 64, 2) mk_fwd(Args args) {
    extern __shared__ __attribute__((aligned(16))) unsigned char lds_raw[];
    LAS unsigned char* lds = (LAS unsigned char*)lds_raw;
    const int G = gridDim.x, lo = args.ph_lo, hi = args.ph_hi;
    unsigned char* ws = args.ws;
    float* ss = (float*)(ws + WS_SS);
    bf16* XB = (bf16*)(ws + WS_XB); bf16* A1 = (bf16*)(ws + WS_A1);
#if MK_MULTI
#define GRID_SYNC() do { } while (0)
#define LOCAL_SYNC() do { } while (0)
#else
    volatile LAS unsigned* MISC = (volatile LAS unsigned*)(lds + MISC_OFF);
    if (threadIdx.x < 32) MISC[threadIdx.x] = 0u;
    __syncthreads();
    XcdBarrier bar = xcd_barrier_post((unsigned*)(ws + WS_CTL), MISC + 8);
    if (threadIdx.x == 0) (void)__hip_atomic_fetch_or(&bar.bar[LB_MASK(bar.x)], 1u << (blockIdx.x & 7), __ATOMIC_RELAXED, __HIP_MEMORY_SCOPE_AGENT);
    bool local_ok = false;
#define GRID_SYNC() xcd_barrier(bar)
#define LOCAL_SYNC() do { if (local_ok) xcc_local_barrier(bar); else xcd_barrier(bar); } while (0)
#endif
#define IN(k) (lo <= (k) && (k) < hi)
    if (IN(0)) { prologue(lds, args, G); __syncthreads(); GRID_SYNC(); }
#if !MK_MULTI
    {
        if (threadIdx.x == 0) {
            unsigned okv = (G == 256) ? 1u : 0u, allm = 0u;
#pragma unroll
            for (unsigned j = 0; j < 16; ++j) { const unsigned cnt = xb_ld(&bar.bar[XB_XCNT(j)]), m = xb_ld(&bar.bar[LB_MASK(j)]);
                if (j < 8) { okv &= (cnt == 32u && m != 0u && (m & (m - 1u)) == 0u) ? 1u : 0u; allm |= m; } else okv &= (cnt == 0u) ? 1u : 0u; }
            okv &= (allm == 0xFFu) ? 1u : 0u;
            okv &= (bar.x < 8u && xb_ld(&bar.bar[LB_MASK(bar.x & 7u)]) == (1u << (blockIdx.x & 7))) ? 1u : 0u;
            MISC[12] = okv;
        }
        __syncthreads();
        local_ok = MISC[12] != 0u;
    }
#endif
    if (IN(1)) {
        pg8::Gemm g{XB, (const bf16*)(ws + WS_W1GU), MTOK, 2 * DFF, DM}; pg8::StaticOrder S; S.init(MTOK, 2 * DFF, G, (int)blockIdx.x, GU_WGM);
        pg8::EpiSwiGLU E{A1, DFF, ss};
        pg8::gemm_phase<pg8::EpiSwiGLU, pg8::StaticOrder, true, true>(lds, g, S, E);
        LOCAL_SYNC();
    }
    if (IN(2)) {
        pg8::Gemm g{A1, (const bf16*)(ws + WS_W1D), MTOK, DM, DFF}; pg8::StaticOrder S; S.init(MTOK, DM, G, (int)blockIdx.x, 8, 1);
        pg8::EpiResid E{XB, ss + MTOK, 0.5f};
        pg8::gemm_phase<pg8::EpiResid, pg8::StaticOrder, true, true>(lds, g, S, E);
        GRID_SYNC();
    }
#if DBG_STOP == 2
    if (IN(9)) final_phase(args, G, 1);
    return;
#endif
    if (IN(3)) {
        pg8::Gemm g{XB, (const bf16*)(ws + WS_WIN), MTOK, NIN, DM}; pg8::StaticOrder S; S.init(MTOK, NIN, G, (int)blockIdx.x);
        pg8::EpiWin E{(bf16*)(ws + WS_U), (bf16*)(ws + WS_Z), ss + MTOK};
        pg8::gemm_phase<pg8::EpiWin, pg8::StaticOrder, true, true>(lds, g, S, E);
        LOCAL_SYNC();
    }
#if DBG_STOP == 3
    if (IN(9)) dbg_dump(args, G, (const bf16*)(ws + WS_U), 512, (const bf16*)(ws + WS_Z), 512);
    return;
#endif
    if (IN(4)) { s5_phase(lds, args, G); conv_phase(args, G); LOCAL_SYNC(); }
#if DBG_STOP == 4
    if (IN(9)) dbg_dump(args, G, (const bf16*)(ws + WS_YS), 512, (const bf16*)(ws + WS_YM) + 512, 1024);
    return;
#endif
    if (IN(5)) {
        pg8::Gemm g{(const bf16*)(ws + WS_YS), (const bf16*)(ws + WS_WGLU), MTOK, S5W, S5W}; pg8::StaticOrder S; S.init(MTOK, S5W, G, (int)blockIdx.x);
        pg8::EpiGlu E{(const bf16*)(ws + WS_YS), (bf16*)(ws + WS_YM), args.in[16]};
        pg8::gemm_phase<pg8::EpiGlu, pg8::StaticOrder, true, true>(lds, g, S, E);
        LOCAL_SYNC();
    }
    if (IN(6)) {
        pg8::Gemm g{(const bf16*)(ws + WS_YM), (const bf16*)(ws + WS_WOUT), MTOK, DM, DM}; pg8::StaticOrder S; S.init(MTOK, DM, G, (int)blockIdx.x);
        pg8::EpiResid E{XB, ss + 2 * MTOK, 1.0f};
        pg8::gemm_phase<pg8::EpiResid, pg8::StaticOrder, true, true>(lds, g, S, E);
        GRID_SYNC();
    }
#if DBG_STOP == 6
    if (IN(9)) final_phase(args, G, 2);
    return;
#endif
    if (IN(7)) {
        pg8::Gemm g{XB, (const bf16*)(ws + WS_W2GU), MTOK, 2 * DFF, DM}; pg8::StaticOrder S; S.init(MTOK, 2 * DFF, G, (int)blockIdx.x, GU_WGM);
        pg8::EpiSwiGLU E{A1, DFF, ss + 2 * MTOK};
        pg8::gemm_phase<pg8::EpiSwiGLU, pg8::StaticOrder, true, true>(lds, g, S, E);
        LOCAL_SYNC();
    }
    if (IN(8)) {
        pg8::Gemm g{A1, (const bf16*)(ws + WS_W2D), MTOK, DM, DFF}; pg8::StaticOrder S; S.init(MTOK, DM, G, (int)blockIdx.x, 8, 1);
        pg8::EpiResid E{XB, ss + 3 * MTOK, 0.5f};
        pg8::gemm_phase<pg8::EpiResid, pg8::StaticOrder, true, true>(lds, g, S, E);
        LOCAL_SYNC();
    }
    if (IN(9)) final_phase(args, G);
#undef IN
}

extern "C" void kernel_launch(void* const* d_in, const int* in_sizes, int n_in, void* d_out, int out_size, void* d_ws, size_t ws_size, hipStream_t stream) {
    static int grid = 0;
    if (grid == 0) {
        if (n_in != 27 || out_size != MTOK * DM || ws_size < WS_END) { fprintf(stderr, "kernel_launch: unexpected shapes (n_in %d out %d ws %zu)\n", n_in, out_size, ws_size); grid = -1; return; }
        int dev = 0, cus = 0, per_cu = 0;
        hipGetDevice(&dev); hipDeviceGetAttribute(&cus, hipDeviceAttributeMultiprocessorCount, dev);
        if (hipFuncSetAttribute((const void*)mk_fwd, hipFuncAttributeMaxDynamicSharedMemorySize, LDS_BYTES) != hipSuccess) { fprintf(stderr, "kernel_launch: hipFuncSetAttribute failed\n"); grid = -1; return; }
        if (hipOccupancyMaxActiveBlocksPerMultiprocessor(&per_cu, (const void*)mk_fwd, NWAVES * 64, LDS_BYTES) != hipSuccess || per_cu < 1) { fprintf(stderr, "kernel_launch: occupancy query says %d\n", per_cu); per_cu = 1; }
        (void)hipGetLastError();
        grid = cus;
    }
    if (grid < 0) return;
    Args a{};
    for (int i = 0; i < 27; ++i) a.in[i] = (const float*)d_in[i];
    a.out = (float*)d_out; a.ws = (unsigned char*)d_ws;
#if MK_MULTI
    for (int p = 0; p < N_PHASES; ++p) { a.ph_lo = p; a.ph_hi = p + 1; hipLaunchKernelGGL(mk_fwd, dim3(grid), dim3(NWAVES * 64), LDS_BYTES, stream, a); }
#else
    a.ph_lo = 0; a.ph_hi = N_PHASES;
    if (hipMemsetAsync((char*)d_ws + WS_CTL, 0, CTL_ZERO_BYTES, stream) != hipSuccess) { fprintf(stderr, "kernel_launch: hipMemsetAsync failed\n"); return; }
    void* kargs[] = {&a};
    hipError_t e = hipLaunchCooperativeKernel((const void*)mk_fwd, dim3(grid), dim3(NWAVES * 64), kargs, LDS_BYTES, stream);
    if (e != hipSuccess) fprintf(stderr, "kernel_launch: cooperative launch failed: %s (grid %d)\n", hipGetErrorString(e), grid);
#endif
}
```

```cpp
#include <hip/hip_runtime.h>
#include <hip/hip_cooperative_groups.h>
#include <cstdio>
#include <cstdint>
namespace cg = cooperative_groups;

#ifndef GU_WGM
#define GU_WGM 4
#endif
#ifndef DBG_STOP
#define DBG_STOP 0
#endif
#ifndef MK_MULTI
#define MK_MULTI 0
#endif

namespace pg8 {
#define PG8_LAS __attribute__((address_space(3)))
typedef unsigned short bf16_t;
typedef short bf16x8 __attribute__((ext_vector_type(8)));
typedef float f32x4 __attribute__((ext_vector_type(4)));
typedef unsigned u32x4 __attribute__((ext_vector_type(4)));
constexpr int BM = 256, BK = 64, HALF = 128, HTB = HALF * BK * 2  , STAGE_BYTES = 8 * HTB, NXCD = 8, WGM = 8;

__host__ __device__ __forceinline__ int lds_byte(int r, int c) { const int st = (r >> 4) * 2 + (c >> 5), rr = r & 15, cc = c & 31, ob = rr * 64 + cc * 2; return st * 1024 + (ob ^ (((ob >> 9) & 1) << 5)); }
__host__ __device__ __forceinline__ void stage_rc(int b, int& R, int& C) { const int st = b / 1024, sb = b % 1024, swz = sb ^ (((sb >> 9) & 1) << 5); R = (st >> 1) * 16 + swz / 64; C = (st & 1) * 32 + (swz % 64) / 2; }
__host__ __device__ __forceinline__ int perm32(int rho) { const int n = rho >> 4, i = rho & 15; return 8 * (i >> 2) + 4 * n + (i & 3); }

struct Unit { int pm, pn; };
struct Gemm { const bf16_t* A; const bf16_t* Bt; int M, N, K; size_t bskip; };

struct StaticOrder {
    int nM, nN, nwg, G, c, wgm, rev;
    __host__ __device__ void init(int M, int N, int G_, int c_, int wgm_ = WGM, int rev_ = 0) { nM = M / BM; nN = N / BM; nwg = nM * nN; G = G_; c = c_; wgm = wgm_; rev = rev_; }
    __host__ __device__ bool next(int i, Unit& u) const {
        const int nr = nwg / G; const bool rv = rev && (nwg % G == 0);
        const long L = (long)((rv && i < nr) ? nr - 1 - i : i) * G + c; if (L >= nwg) return false;
        int wgid = (int)L; { const int q = nwg / NXCD, r = nwg % NXCD, xcd = wgid % NXCD, off = wgid / NXCD; wgid = (xcd < r ? xcd * (q + 1) : r * (q + 1) + (xcd - r) * q) + off; }
        const int nig = wgm * nN, gid = wgid / nig, fm = gid * wgm, gsz = (nM - fm) < wgm ? (nM - fm) : wgm;
        u.pm = fm + ((wgid % nig) % gsz); u.pn = (wgid % nig) / gsz; return true;
    }
    __device__ __forceinline__ void a_ready(const Unit&) const {}
    __device__ __forceinline__ void done(const Unit&) const {}
};

typedef __bf16 bf16v2_t __attribute__((ext_vector_type(2)));
typedef float f32v2_t __attribute__((ext_vector_type(2)));
__device__ __forceinline__ unsigned cvt_pk_bf16(float lo, float hi) { const f32v2_t f = {lo, hi}; const bf16v2_t r = __builtin_convertvector(f, bf16v2_t); return __builtin_bit_cast(unsigned, r); }
typedef float f32x2 __attribute__((ext_vector_type(2)));
typedef unsigned u32x2 __attribute__((ext_vector_type(2)));
template <class Epi, class Sched, bool ALIGN_EPI = false, bool SP2 = false>
__device__ __forceinline__ void gemm_phase(PG8_LAS unsigned char* lds, const Gemm g, const Sched& S, const Epi& E) {
    const int tid = threadIdx.x, wid = __builtin_amdgcn_readfirstlane(tid >> 6), lane = tid & 63, wr = wid >> 2, wc = wid & 3, fr = lane & 15, fq = lane >> 4;
    const int K = g.K, nt = K / BK;
    unsigned voffA[2], voffB[2];
#pragma unroll
    for (int i = 0; i < 2; ++i) { int R, C; stage_rc(tid * 16 + i * 8192, R, C); const int Rb = Epi::PERM ? ((R & ~31) + perm32(R & 31)) : R;
        voffA[i] = (unsigned)(R * K + C) * 2u; voffB[i] = (unsigned)(Rb * K + C) * 2u; }
    const size_t kstep = (size_t)(BK * 2);
    const size_t hstep = (size_t)HALF * K * 2;
    const size_t tstep = 2 * hstep;
    const unsigned ldsw = (unsigned)wid * 1024u;
    const int aoff = lds_byte(wr * 64 + fr, fq * 8), boff = lds_byte(wc * 32 + fr, fq * 8);
#define PG8_SA(b, h) (((b) * 2 + (h)) * HTB)
#define PG8_SB(b, h) ((4 + (b) * 2 + (h)) * HTB)
#define PG8_STAGE(bufoff, gbase, voff) do { _Pragma("unroll") for (int _i = 0; _i < 2; ++_i) \
        __builtin_amdgcn_global_load_lds((const unsigned*)((const char*)(gbase) + (voff)[_i]), (PG8_LAS unsigned*)(lds + (bufoff) + ldsw + _i * 8192), 16, 0, 0); } while (0)
#define PG8_LDA(dst, b, h) do { _Pragma("unroll") for (int m = 0; m < 4; ++m) _Pragma("unroll") for (int k = 0; k < 2; ++k) dst[m][k] = *(const PG8_LAS bf16x8*)(lds + PG8_SA(b, h) + aoff + m * 2048 + k * 1024); } while (0)
#define PG8_LDB(dst, b, h) do { _Pragma("unroll") for (int n = 0; n < 2; ++n) _Pragma("unroll") for (int k = 0; k < 2; ++k) dst[n][k] = *(const PG8_LAS bf16x8*)(lds + PG8_SB(b, h) + boff + n * 2048 + k * 1024); } while (0)
#define PG8_MMA(ai, bj, At, Bt) do { __builtin_amdgcn_s_setprio(1); _Pragma("unroll") for (int m = 0; m < 4; ++m) _Pragma("unroll") for (int n = 0; n < 2; ++n) _Pragma("unroll") for (int k = 0; k < 2; ++k) \
        acc[ai][bj][m][n] = __builtin_amdgcn_mfma_f32_16x16x32_bf16(Bt[n][k], At[m][k], acc[ai][bj][m][n], 0, 0, 0); __builtin_amdgcn_s_setprio(0); } while (0)
#define PG8_WAIT_V(n) asm volatile("s_waitcnt vmcnt(" #n ")" ::: "memory")
#define PG8_WAIT_L(n) asm volatile("s_waitcnt lgkmcnt(" #n ")" ::: "memory")
#define PG8_BAR __builtin_amdgcn_s_barrier()
#define PG8_SCHED __builtin_amdgcn_sched_barrier(0)
    Unit cur, nxt; int ui = 0;
    if (!S.next(0, cur)) return;
    f32x4 acc[2][2][4][2];
#pragma unroll
    for (int a = 0; a < 2; ++a)
#pragma unroll
        for (int b = 0; b < 2; ++b)
#pragma unroll
            for (int m = 0; m < 4; ++m)
#pragma unroll
                for (int n = 0; n < 2; ++n) acc[a][b][m][n] = (f32x4){0.f, 0.f, 0.f, 0.f};
    bf16x8 At[4][2], B0[2][2], B1[2][2];
    const char* cA = (const char*)g.A + (size_t)cur.pm * tstep + (size_t)(cur.pm >> 4) * g.bskip; const char* cB = (const char*)g.Bt + (size_t)cur.pn * tstep;
    S.a_ready(cur);
    if constexpr (SP2) {
        PG8_STAGE(PG8_SB(0, 0), cB, voffB); PG8_STAGE(PG8_SB(0, 1), cB + hstep, voffB); PG8_STAGE(PG8_SA(0, 0), cA, voffA); PG8_STAGE(PG8_SA(0, 1), cA + hstep, voffA);
        if (wr == 1) PG8_BAR;
        PG8_WAIT_V(2); PG8_BAR;
        PG8_STAGE(PG8_SB(1, 0), cB + kstep, voffB); PG8_STAGE(PG8_SA(1, 0), cA + kstep, voffA); PG8_STAGE(PG8_SB(1, 1), cB + hstep + kstep, voffB);
        PG8_WAIT_V(6); PG8_BAR;
    } else {
        PG8_STAGE(PG8_SB(0, 0), cB, voffB); PG8_STAGE(PG8_SA(0, 0), cA, voffA); PG8_STAGE(PG8_SB(0, 1), cB + hstep, voffB); PG8_STAGE(PG8_SA(0, 1), cA + hstep, voffA);
        if (wr == 1) PG8_BAR;
        PG8_WAIT_V(4); PG8_BAR;
        PG8_STAGE(PG8_SB(1, 0), cB + kstep, voffB); PG8_STAGE(PG8_SA(1, 0), cA + kstep, voffA); PG8_STAGE(PG8_SB(1, 1), cB + hstep + kstep, voffB);
        PG8_WAIT_V(6); PG8_BAR;
    }
    for (;;) {
        const bool has_next = S.next(ui + 1, nxt);
        const char* nA = has_next ? (const char*)g.A + (size_t)nxt.pm * tstep + (size_t)(nxt.pm >> 4) * g.bskip : cA; const char* nB = has_next ? (const char*)g.Bt + (size_t)nxt.pn * tstep : cB;
        typename Epi::Pre pre; E.prefetch(cur, wr, wc, fr, fq, pre);
        for (int t = 0; t < nt; t += 2) {
            const bool last = (t == nt - 2);
            const char* a1 = cA + (size_t)(t + 1) * kstep;
            const char* a2 = last ? nA : cA + (size_t)(t + 2) * kstep; const char* b2 = last ? nB : cB + (size_t)(t + 2) * kstep;
            const char* a3 = a2 + kstep; const char* b3 = b2 + kstep;
            if (last && has_next) S.a_ready(nxt);
            if constexpr (SP2) {
            PG8_LDB(B0, 0, 0); PG8_LDB(B1, 0, 1); PG8_SCHED; PG8_LDA(At, 0, 0); PG8_STAGE(PG8_SA(1, 1), a1 + hstep, voffA);
            PG8_WAIT_V(8); PG8_WAIT_L(0); PG8_BAR; PG8_MMA(0, 0, At, B0); PG8_MMA(0, 1, At, B1); PG8_BAR; PG8_SCHED;
            PG8_LDA(At, 0, 1); PG8_STAGE(PG8_SB(0, 0), b2, voffB); PG8_STAGE(PG8_SB(0, 1), b2 + hstep, voffB); PG8_STAGE(PG8_SA(0, 0), a2, voffA);
            PG8_WAIT_V(8); PG8_WAIT_L(0); PG8_BAR; PG8_MMA(1, 0, At, B0); PG8_MMA(1, 1, At, B1); PG8_BAR; PG8_SCHED;
            PG8_LDB(B0, 1, 0); PG8_LDB(B1, 1, 1); PG8_SCHED; PG8_LDA(At, 1, 0); PG8_STAGE(PG8_SA(0, 1), a2 + hstep, voffA);
            PG8_WAIT_V(8); PG8_WAIT_L(0); PG8_BAR; PG8_MMA(0, 0, At, B0); PG8_MMA(0, 1, At, B1); PG8_BAR; PG8_SCHED;
            PG8_LDA(At, 1, 1); PG8_STAGE(PG8_SB(1, 0), b3, voffB); PG8_STAGE(PG8_SB(1, 1), b3 + hstep, voffB); PG8_STAGE(PG8_SA(1, 0), a3, voffA);
            PG8_WAIT_V(8); PG8_WAIT_L(0); PG8_BAR; PG8_MMA(1, 0, At, B0); PG8_MMA(1, 1, At, B1); PG8_BAR; PG8_SCHED;
            } else {
            PG8_LDB(B0, 0, 0); PG8_SCHED; PG8_LDA(At, 0, 0); PG8_STAGE(PG8_SA(1, 1), a1 + hstep, voffA);
            PG8_WAIT_L(8); PG8_BAR; PG8_WAIT_L(0); PG8_MMA(0, 0, At, B0); PG8_BAR; PG8_SCHED;
            PG8_LDB(B1, 0, 1); PG8_STAGE(PG8_SB(0, 0), b2, voffB);
            PG8_BAR; PG8_WAIT_L(0); PG8_MMA(0, 1, At, B1); PG8_BAR;
            PG8_LDA(At, 0, 1); PG8_STAGE(PG8_SA(0, 0), a2, voffA);
            PG8_BAR; PG8_WAIT_L(0); PG8_MMA(1, 0, At, B0); PG8_BAR; PG8_SCHED;
            PG8_STAGE(PG8_SB(0, 1), b2 + hstep, voffB);
            PG8_WAIT_V(6); PG8_BAR; PG8_MMA(1, 1, At, B1); PG8_BAR;
            PG8_LDB(B0, 1, 0); PG8_SCHED; PG8_LDA(At, 1, 0); PG8_STAGE(PG8_SA(0, 1), a2 + hstep, voffA);
            PG8_WAIT_L(8); PG8_BAR; PG8_WAIT_L(0); PG8_MMA(0, 0, At, B0); PG8_BAR; PG8_SCHED;
            PG8_LDB(B1, 1, 1); PG8_STAGE(PG8_SB(1, 0), b3, voffB);
            PG8_BAR; PG8_WAIT_L(0); PG8_MMA(0, 1, At, B1); PG8_BAR;
            PG8_LDA(At, 1, 1); PG8_STAGE(PG8_SA(1, 0), a3, voffA);
            PG8_BAR; PG8_WAIT_L(0); PG8_MMA(1, 0, At, B0); PG8_BAR; PG8_SCHED;
            PG8_STAGE(PG8_SB(1, 1), b3 + hstep, voffB);
            PG8_WAIT_V(6); PG8_BAR; PG8_MMA(1, 1, At, B1); PG8_BAR;
            }
        }
        if constexpr (ALIGN_EPI) { if (wr == 0) PG8_BAR; }
        if constexpr (!Epi::AFTER_DRAIN) { E(acc, cur, wr, wc, fr, fq, pre); S.done(cur); }
        if (!has_next) break;
#pragma unroll
        for (int a = 0; a < 2; ++a)
#pragma unroll
            for (int b = 0; b < 2; ++b)
#pragma unroll
                for (int m = 0; m < 4; ++m)
#pragma unroll
                    for (int n = 0; n < 2; ++n) acc[a][b][m][n] = (f32x4){0.f, 0.f, 0.f, 0.f};
        cur = nxt; cA = nA; cB = nB; ++ui;
        if constexpr (ALIGN_EPI) { if (wr == 1) PG8_BAR; }
    }
    PG8_WAIT_V(0);
    if constexpr (!ALIGN_EPI) { if (wr == 0) PG8_BAR; }
    PG8_BAR;
    if constexpr (Epi::AFTER_DRAIN) { E.fused(acc, cur, wr, wc, fr, fq, lds, wid, lane); S.done(cur); }
#undef PG8_SA
#undef PG8_SB
#undef PG8_STAGE
#undef PG8_LDA
#undef PG8_LDB
#undef PG8_MMA
#undef PG8_WAIT_V
#undef PG8_WAIT_L
#undef PG8_BAR
#undef PG8_SCHED
}
}

constexpr int DM = 1024, BATCH = 8, SEQ = 4096, MTOK = BATCH * SEQ, DFF = 2816, S5W = 512, CVW = 512, NIN = 1536;
constexpr int NG = 32, NP = 64, NC = 16, CK = 31;
constexpr float EPS = 1e-6f;
constexpr int NWAVES = 8;
constexpr int LDS_BYTES = 147456;

constexpr size_t MiB = 1u << 20;
constexpr size_t WS_SS = 1 * MiB;
constexpr size_t WS_S5A = 2 * MiB;
constexpr size_t WS_S5AT = WS_S5A + 16384;
constexpr size_t WS_S5BF = WS_S5A + 65536;
constexpr size_t WS_S5CF = WS_S5BF + 262144;
constexpr size_t WS_W1GU = 4 * MiB;
constexpr size_t WS_W1D = 15 * MiB;
constexpr size_t WS_WIN = 21 * MiB;
constexpr size_t WS_WGLU = 24 * MiB;
constexpr size_t WS_WOUT = 25 * MiB;
constexpr size_t WS_W2GU = 27 * MiB;
constexpr size_t WS_W2D = 38 * MiB;
constexpr size_t WS_XB = 48 * MiB;
constexpr size_t WS_A1 = 112 * MiB;
constexpr size_t WS_U = WS_A1 + 0 * MiB;
constexpr size_t WS_Z = WS_A1 + 4 * MiB;
constexpr size_t WS_YS = WS_A1 + 8 * MiB;
constexpr size_t WS_YM = WS_A1 + 12 * MiB;
constexpr size_t WS_END = 448 * MiB;
constexpr size_t BST_EL = (size_t)4096 * 2816;
constexpr size_t SK512 = BST_EL - (size_t)4096 * 512;
constexpr size_t SK1024 = BST_EL - (size_t)4096 * 1024;

#define LAS __attribute__((address_space(3)))
typedef unsigned short bf16;
typedef float f32x4 __attribute__((ext_vector_type(4)));
typedef float f32x2 __attribute__((ext_vector_type(2)));
typedef short bf16x8 __attribute__((ext_vector_type(8)));
typedef short bf16x4 __attribute__((ext_vector_type(4)));
typedef unsigned u32x4 __attribute__((ext_vector_type(4)));
typedef unsigned u32x2 __attribute__((ext_vector_type(2)));

__device__ __forceinline__ float bf2f(unsigned short b) { return __uint_as_float(((unsigned)b) << 16); }
__device__ __forceinline__ float fast_sigmoid(float x) { return __builtin_amdgcn_rcpf(1.0f + __expf(-x)); }

template <int CTRL> __device__ __forceinline__ float dpp_mov(float v) {
    return __builtin_bit_cast(float, __builtin_amdgcn_update_dpp(0, __builtin_bit_cast(int, v), CTRL, 0xF, 0xF, true));
}
__device__ __forceinline__ float wave_sum(float v) {
    v += dpp_mov<0xB1>(v);
    v += dpp_mov<0x4E>(v);
    v += dpp_mov<0x141>(v);
    v += dpp_mov<0x140>(v);
    v += __shfl_xor(v, 16);
    v += __shfl_xor(v, 32);
    return v;
}

struct Args { const float* in[27]; float* out; unsigned char* ws; int ph_lo, ph_hi; };

namespace pg8 {
struct EpiSwiGLU {
    static constexpr bool PERM = true, AFTER_DRAIN = false;
    bf16_t* O; int ldc; const float* ss;
    struct Pre { float v[8]; };
    __device__ __forceinline__ void prefetch(const Unit& u, int wr, int wc, int fr, int fq, Pre& p) const {
        const int row0 = u.pm * BM + wr * 64 + fr;
#pragma unroll
        for (int i = 0; i < 8; ++i) p.v[i] = ss[row0 + (i >> 2) * HALF + (i & 3) * 16];
    }
    __device__ __forceinline__ void operator()(const f32x4 (&acc)[2][2][4][2], const Unit& u, int wr, int wc, int fr, int fq, const Pre& pre) const {
        const int row0 = u.pm * BM + wr * 64 + fr, col0 = u.pn * 128 + wc * 32 + 8 * fq;
#pragma unroll
        for (int ai = 0; ai < 2; ++ai)
#pragma unroll
            for (int m = 0; m < 4; ++m) {
                const int row = row0 + ai * HALF + m * 16;
                const float rs = __builtin_amdgcn_rsqf(pre.v[ai * 4 + m] * (1.0f / 1024.0f) + 1e-6f);
                float h[8];
#pragma unroll
                for (int n = 0; n < 2; ++n)
#pragma unroll
                    for (int j = 0; j < 4; ++j) { const float g = acc[ai][0][m][n][j] * rs, up = acc[ai][1][m][n][j] * rs; h[4 * n + j] = g * up * __builtin_amdgcn_rcpf(1.0f + __expf(-g)); }
                u32x4 w; w.x = cvt_pk_bf16(h[0], h[1]); w.y = cvt_pk_bf16(h[2], h[3]); w.z = cvt_pk_bf16(h[4], h[5]); w.w = cvt_pk_bf16(h[6], h[7]);
                *(u32x4*)(O + (size_t)row * ldc + col0) = w;
            }
    }
};
struct EpiResid {
    static constexpr bool PERM = true, AFTER_DRAIN = false;
    bf16_t* XB; float* ss; float scale;
    struct Pre { };
    __device__ __forceinline__ void prefetch(const Unit&, int, int, int, int, Pre&) const {}
    __device__ __forceinline__ void operator()(const f32x4 (&acc)[2][2][4][2], const Unit& u, int wr, int wc, int fr, int fq, const Pre&) const {
        const int row0 = u.pm * BM + wr * 64 + fr, col0 = u.pn * BM + wc * 32 + 8 * fq;
#pragma unroll
        for (int ai = 0; ai < 2; ++ai)
#pragma unroll
            for (int m = 0; m < 4; ++m) {
                const int row = row0 + ai * HALF + m * 16; bf16_t* p = XB + (size_t)row * 1024 + col0; float q = 0.f;
                const u32x4 r0 = *(const u32x4*)p, r1 = *(const u32x4*)(p + HALF);
#pragma unroll
                for (int bj = 0; bj < 2; ++bj) {
                    const u32x4 rv = bj ? r1 : r0; float v[8];
#pragma unroll
                    for (int e = 0; e < 8; ++e) { const unsigned wd = rv[e >> 1]; const float x = __uint_as_float((e & 1) ? (wd & 0xffff0000u) : (wd << 16));
                        v[e] = fmaf(acc[ai][bj][m][e >> 2][e & 3], scale, x); q = fmaf(v[e], v[e], q); }
                    u32x4 w; w.x = cvt_pk_bf16(v[0], v[1]); w.y = cvt_pk_bf16(v[2], v[3]); w.z = cvt_pk_bf16(v[4], v[5]); w.w = cvt_pk_bf16(v[6], v[7]);
                    *(u32x4*)(p + bj * HALF) = w;
                }
                q += __shfl_xor(q, 16); q += __shfl_xor(q, 32);
                if (fq == 0) atomicAdd(ss + row, q);
            }
    }
};
struct EpiWin {
    static constexpr bool PERM = true, AFTER_DRAIN = false;
    bf16_t* U; bf16_t* Z; const float* ss;
    struct Pre { float v[8]; };
    __device__ __forceinline__ void prefetch(const Unit& u, int wr, int wc, int fr, int fq, Pre& p) const {
        const int row0 = u.pm * BM + wr * 64 + fr;
#pragma unroll
        for (int i = 0; i < 8; ++i) p.v[i] = ss[row0 + (i >> 2) * HALF + (i & 3) * 16];
    }
    __device__ __forceinline__ void operator()(const f32x4 (&acc)[2][2][4][2], const Unit& u, int wr, int wc, int fr, int fq, const Pre& pre) const {
        const int row0 = u.pm * BM + wr * 64 + fr, cw = wc * 32 + 8 * fq;
#pragma unroll
        for (int ai = 0; ai < 2; ++ai)
#pragma unroll
            for (int m = 0; m < 4; ++m) {
                const int row = row0 + ai * HALF + m * 16;
                const float rs = __builtin_amdgcn_rsqf(pre.v[ai * 4 + m] * (1.0f / 1024.0f) + 1e-6f);
                if (u.pn < 2) {
#pragma unroll
                    for (int bj = 0; bj < 2; ++bj) { const f32x4 v0 = acc[ai][bj][m][0] * rs, v1 = acc[ai][bj][m][1] * rs;
                        u32x4 w; w.x = cvt_pk_bf16(v0[0], v0[1]); w.y = cvt_pk_bf16(v0[2], v0[3]); w.z = cvt_pk_bf16(v1[0], v1[1]); w.w = cvt_pk_bf16(v1[2], v1[3]);
                        *(u32x4*)(U + (size_t)(u.pm >> 4) * SK512 + (size_t)row * 512 + u.pn * 256 + bj * HALF + cw) = w; }
                } else {
                    float h[8];
#pragma unroll
                    for (int n = 0; n < 2; ++n)
#pragma unroll
                        for (int j = 0; j < 4; ++j) { const float a = acc[ai][0][m][n][j] * rs, g = acc[ai][1][m][n][j] * rs; h[4 * n + j] = a * __builtin_amdgcn_rcpf(1.0f + __expf(-g)); }
                    u32x4 w; w.x = cvt_pk_bf16(h[0], h[1]); w.y = cvt_pk_bf16(h[2], h[3]); w.z = cvt_pk_bf16(h[4], h[5]); w.w = cvt_pk_bf16(h[6], h[7]);
                    *(u32x4*)(Z + (size_t)(u.pm >> 4) * SK512 + (size_t)row * 512 + (u.pn - 2) * 128 + cw) = w;
                }
            }
    }
};
struct EpiGlu {
    static constexpr bool PERM = true, AFTER_DRAIN = false;
    const bf16_t* YS; bf16_t* YM; const float* bias;
    struct Pre { };
    __device__ __forceinline__ void prefetch(const Unit&, int, int, int, int, Pre&) const {}
    __device__ __forceinline__ void operator()(const f32x4 (&acc)[2][2][4][2], const Unit& u, int wr, int wc, int fr, int fq, const Pre&) const {
        const int row0 = u.pm * BM + wr * 64 + fr, col0 = u.pn * BM + wc * 32 + 8 * fq;
        f32x4 bv[2][2];
#pragma unroll
        for (int bj = 0; bj < 2; ++bj)
#pragma unroll
            for (int n = 0; n < 2; ++n) bv[bj][n] = *(const f32x4*)(bias + col0 + bj * HALF + 4 * n);
#pragma unroll
        for (int ai = 0; ai < 2; ++ai)
#pragma unroll
            for (int m = 0; m < 4; ++m) {
                const int row = row0 + ai * HALF + m * 16;
#pragma unroll
                for (int bj = 0; bj < 2; ++bj) {
                    const u32x4 yv = *(const u32x4*)(YS + (size_t)(u.pm >> 4) * SK512 + (size_t)row * 512 + col0 + bj * HALF);
                    float h[8];
#pragma unroll
                    for (int n = 0; n < 2; ++n)
#pragma unroll
                        for (int j = 0; j < 4; ++j) { const int e = 4 * n + j; const unsigned wd = yv[e >> 1]; const float y = __uint_as_float((e & 1) ? (wd & 0xffff0000u) : (wd << 16));
                            const float g = acc[ai][bj][m][n][j] + bv[bj][n][j]; h[e] = y * __builtin_amdgcn_rcpf(1.0f + __expf(-g)); }
                    u32x4 w; w.x = cvt_pk_bf16(h[0], h[1]); w.y = cvt_pk_bf16(h[2], h[3]); w.z = cvt_pk_bf16(h[4], h[5]); w.w = cvt_pk_bf16(h[6], h[7]);
                    *(u32x4*)(YM + (size_t)(u.pm >> 4) * SK1024 + (size_t)row * 1024 + col0 + bj * HALF) = w;
                }
            }
    }
};
}

__device__ __forceinline__ unsigned f2bf(float f) { unsigned u = __float_as_uint(f); return (u + 0x7fffu + ((u >> 16) & 1u)) >> 16; }
__device__ __forceinline__ unsigned pk2(float lo, float hi) { return f2bf(lo) | (f2bf(hi) << 16); }

__device__ __forceinline__ int rowmap(int mode, int n0) {
    if (mode == 1) return 256 * (n0 >> 7) + (n0 & 127);
    if (mode == 2) return 256 * (n0 >> 7) + 128 + (n0 & 127);
    if (mode == 3) { if (n0 < 512) return n0; if (n0 < 1024) { const int j = n0 - 512; return 512 + 256 * (j >> 7) + (j & 127); } const int j = n0 - 1024; return 512 + 256 * (j >> 7) + 128 + (j & 127); }
    return n0;
}
__device__ __forceinline__ void transpose_item(const float* W, int K, int N, const float* gain, bf16* WT, int mode, LAS float* scr, int item, int lane) {
    const int nblk = N / 32, kb = item / nblk, nb = item % nblk, k0 = 64 * kb, n0 = 32 * nb;
    float wv[32];
#pragma unroll
    for (int i = 0; i < 32; ++i) { const int kk = 2 * i + (lane >> 5); wv[i] = __builtin_nontemporal_load(&W[(size_t)(k0 + kk) * N + n0 + (lane & 31)]); }
    if (gain) {
#pragma unroll
        for (int i = 0; i < 32; ++i) wv[i] *= gain[k0 + 2 * i + (lane >> 5)]; }
#pragma unroll
    for (int i = 0; i < 32; ++i) scr[(2 * i + (lane >> 5)) * 33 + (lane & 31)] = wv[i];
    asm volatile("s_waitcnt lgkmcnt(0)" ::: "memory");
    const int c = lane & 7, d0 = rowmap(mode, n0);
#pragma unroll
    for (int j = 0; j < 4; ++j) { const int n = (lane >> 3) + 8 * j; const LAS float* s = scr + (8 * c) * 33 + n;
        u32x4 o; o.x = pg8::cvt_pk_bf16(s[0 * 33], s[1 * 33]); o.y = pg8::cvt_pk_bf16(s[2 * 33], s[3 * 33]); o.z = pg8::cvt_pk_bf16(s[4 * 33], s[5 * 33]); o.w = pg8::cvt_pk_bf16(s[6 * 33], s[7 * 33]);
        *(u32x4*)(WT + (size_t)(d0 + n) * K + k0 + 8 * c) = o; }
    asm volatile("s_waitcnt lgkmcnt(0)" ::: "memory");
}

__device__ __forceinline__ void my_sincos(float x, float& s, float& c) {
    const float q = rintf(x * 0.636619772367581f);
    float r = fmaf(-q, 1.5703125f, x); r = fmaf(-q, 4.837512969970703e-4f, r); r = fmaf(-q, 7.549789954891882e-8f, r);
    const float z = r * r;
    const float sp = r + r * z * (-1.6666654611e-1f + z * (8.3321608736e-3f + z * (-1.9515295891e-4f)));
    const float cp = 1.0f - 0.5f * z + z * z * (4.166664568298827e-2f + z * (-1.388731625493765e-3f + z * 2.443315711809948e-5f));
    const int qi = ((int)q) & 3;
    s = (qi == 0) ? sp : (qi == 1) ? cp : (qi == 2) ? -sp : -cp;
    c = (qi == 0) ? cp : (qi == 1) ? -sp : (qi == 2) ? -cp : sp;
}
__device__ __forceinline__ void s5_coeffs(const Args& A, int g, int p, float& ar, float& ai, float& fre, float& fim) {
    const float lr = A.in[7][g * NP + p], li = A.in[8][g * NP + p], dt = expf(A.in[9][g]);
    const float mag = expf(lr * dt); float s, c; my_sincos(li * dt, s, c); ar = mag * c; ai = mag * s;
    const float den = lr * lr + li * li, nr = ar - 1.0f, ni = ai;
    fre = (nr * lr + ni * li) / den; fim = (ni * lr - nr * li) / den;
}

__device__ __forceinline__ void prologue(LAS unsigned char* lds, const Args& A, int G) {
    const int tid = threadIdx.x, lane = tid & 63, wave = __builtin_amdgcn_readfirstlane(tid >> 6);
    unsigned char* ws = A.ws;
    LAS float* scr = (LAS float*)(lds + wave * 16384);
    const int gw = blockIdx.x * NWAVES + wave, NGW = G * NWAVES;
    constexpr int I_GU = (DM / 64) * (DFF / 32), I_DN = (DFF / 64) * (DM / 32), I_IN = (DM / 64) * (NIN / 32), I_GL = (S5W / 64) * (S5W / 32), I_OUT = (DM / 64) * (DM / 32);
    constexpr int NITEMS = 4 * I_GU + 2 * I_DN + I_IN + I_GL + I_OUT;
    for (int it = gw; it < NITEMS; it += NGW) {
        int r = it;
        if (r < I_GU) { transpose_item(A.in[2], DM, DFF, A.in[1], (bf16*)(ws + WS_W1GU), 1, scr, r, lane); continue; } r -= I_GU;
        if (r < I_GU) { transpose_item(A.in[3], DM, DFF, A.in[1], (bf16*)(ws + WS_W1GU), 2, scr, r, lane); continue; } r -= I_GU;
        if (r < I_DN) { transpose_item(A.in[4], DFF, DM, nullptr, (bf16*)(ws + WS_W1D), 0, scr, r, lane); continue; } r -= I_DN;
        if (r < I_IN) { transpose_item(A.in[6], DM, NIN, A.in[5], (bf16*)(ws + WS_WIN), 3, scr, r, lane); continue; } r -= I_IN;
        if (r < I_GL) { transpose_item(A.in[15], S5W, S5W, nullptr, (bf16*)(ws + WS_WGLU), 0, scr, r, lane); continue; } r -= I_GL;
        if (r < I_OUT) { transpose_item(A.in[21], DM, DM, nullptr, (bf16*)(ws + WS_WOUT), 0, scr, r, lane); continue; } r -= I_OUT;
        if (r < I_GU) { transpose_item(A.in[23], DM, DFF, A.in[22], (bf16*)(ws + WS_W2GU), 1, scr, r, lane); continue; } r -= I_GU;
        if (r < I_GU) { transpose_item(A.in[24], DM, DFF, A.in[22], (bf16*)(ws + WS_W2GU), 2, scr, r, lane); continue; } r -= I_GU;
        transpose_item(A.in[25], DFF, DM, nullptr, (bf16*)(ws + WS_W2D), 0, scr, r, lane);
    }
    float* ss = (float*)(ws + WS_SS);
    bf16* XB = (bf16*)(ws + WS_XB);
    for (int row = 4 * gw; row < MTOK; row += 4 * NGW) {
        f32x4 v[4][4];
#pragma unroll
        for (int r = 0; r < 4; ++r) { const f32x4* xr = (const f32x4*)(A.in[0] + (size_t)(row + r) * DM) + lane;
#pragma unroll
            for (int j = 0; j < 4; ++j) v[r][j] = __builtin_nontemporal_load(&xr[64 * j]); }
#pragma unroll
        for (int r = 0; r < 4; ++r) { float sq = 0.f;
#pragma unroll
            for (int j = 0; j < 4; ++j) sq += (v[r][j][0] * v[r][j][0] + v[r][j][1] * v[r][j][1]) + (v[r][j][2] * v[r][j][2] + v[r][j][3] * v[r][j][3]);
            sq = wave_sum(sq);
            if (lane == 0) ss[row + r] = sq;
            u32x2* o = (u32x2*)(XB + (size_t)(row + r) * DM) + lane;
#pragma unroll
            for (int j = 0; j < 4; ++j) { u32x2 w; w.x = pg8::cvt_pk_bf16(v[r][j][0], v[r][j][1]); w.y = pg8::cvt_pk_bf16(v[r][j][2], v[r][j][3]); o[64 * j] = w; } }
    }
    const int gt = blockIdx.x * (NWAVES * 64) + tid, NT = G * NWAVES * 64;
    for (int i = gt; i < 3 * MTOK; i += NT) ss[MTOK + i] = 0.f;
    f32x2* abar = (f32x2*)(ws + WS_S5A); f32x2* abarT = (f32x2*)(ws + WS_S5AT);
    u32x4* bfrag = (u32x4*)(ws + WS_S5BF); u32x4* cfrag = (u32x4*)(ws + WS_S5CF);
    for (int i = gt; i < NG * NP; i += NT) {
        const int g = i / NP, p = i % NP; float ar, ai, fre, fim; s5_coeffs(A, g, p, ar, ai, fre, fim);
        abar[i] = (f32x2){ar, ai};
        float tr = ar, ti = ai;
#pragma unroll
        for (int k = 0; k < 5; ++k) { const float nr = tr * tr - ti * ti, ni = 2.0f * tr * ti; tr = nr; ti = ni; }
        abarT[i] = (f32x2){tr, ti};
    }
    for (int i = gt; i < NG * 8 * 64; i += NT) {
        const int ln = i & 63, nt = (i >> 6) & 7, g = i >> 9, p = 16 * (nt & 3) + (ln & 15), c0 = 8 * (ln >> 4);
        u32x4 o = (u32x4){0u, 0u, 0u, 0u};
        if (c0 < 16) {
            float ar, ai, fre, fim; s5_coeffs(A, g, p, ar, ai, fre, fim);
            const float* br = A.in[10] + ((size_t)g * NP + p) * NC + c0; const float* bi = A.in[11] + ((size_t)g * NP + p) * NC + c0;
            float v[8];
#pragma unroll
            for (int k = 0; k < 8; ++k) v[k] = (nt < 4) ? (fre * br[k] - fim * bi[k]) : (fre * bi[k] + fim * br[k]);
            o.x = pk2(v[0], v[1]); o.y = pk2(v[2], v[3]); o.z = pk2(v[4], v[5]); o.w = pk2(v[6], v[7]);
        }
        bfrag[i] = o;
    }
    for (int i = gt; i < NG * 4 * 64; i += NT) {
        const int ln = i & 63, ks = (i >> 6) & 3, g = i >> 8, c = ln & 15, p0 = 16 * ks + 4 * (ln >> 4);
        const float* cr = A.in[12] + ((size_t)g * NC + c) * NP + p0; const float* ci = A.in[13] + ((size_t)g * NC + c) * NP + p0;
        u32x4 o; o.x = pk2(cr[0], -ci[0]); o.y = pk2(cr[1], -ci[1]); o.z = pk2(cr[2], -ci[2]); o.w = pk2(cr[3], -ci[3]);
        cfrag[i] = o;
    }
}

constexpr int XS_PITCH = 68;
constexpr int XS_WAVE_BYTES = 32 * XS_PITCH * 4;
constexpr int CARRY_OFF = NWAVES * XS_WAVE_BYTES;
__device__ __forceinline__ void s5_phase(LAS unsigned char* lds, const Args& A, int G) {
    const int tid = threadIdx.x, lane = tid & 63, w = __builtin_amdgcn_readfirstlane(tid >> 6), fr = lane & 15, fq = lane >> 4;
    unsigned char* ws = A.ws;
    LAS unsigned* xs = (LAS unsigned*)(lds + w * XS_WAVE_BYTES);
    LAS f32x2* carry = (LAS f32x2*)(lds + CARRY_OFF);
    const f32x2* abar = (const f32x2*)(ws + WS_S5A); const f32x2* abarT = (const f32x2*)(ws + WS_S5AT);
    const bf16x8* bfrag = (const bf16x8*)(ws + WS_S5BF); const bf16x8* cfrag = (const bf16x8*)(ws + WS_S5CF);
    const bf16* U = (const bf16*)(ws + WS_U); bf16* YS = (bf16*)(ws + WS_YS);
    for (int item = blockIdx.x; item < BATCH * NG; item += G) {
        const int b = item & (BATCH - 1), g = (item >> 3) & (NG - 1);
        const f32x2 a = abar[g * NP + lane], aT = abarT[g * NP + lane];
        bf16x8 bfr[8], cfr[4];
#pragma unroll
        for (int nt = 0; nt < 8; ++nt) bfr[nt] = bfrag[(g * 8 + nt) * 64 + lane];
#pragma unroll
        for (int ks = 0; ks < 4; ++ks) cfr[ks] = cfrag[(g * 4 + ks) * 64 + lane];
        const f32x4 dsk = *(const f32x4*)(A.in[14] + g * NC + 4 * fq);
        const bf16* Ub = U + (size_t)b * (SEQ * S5W + SK512) + g * NC;
        bf16* Yb = YS + (size_t)b * (SEQ * S5W + SK512) + g * NC;
        float xr = 0.f, xi = 0.f;
        bf16x8 uf[2]; u32x2 usk[2];
#pragma unroll
        for (int mt = 0; mt < 2; ++mt) { const size_t t = (size_t)(32 * w + 16 * mt + fr);
            uf[mt] = (bf16x8){0, 0, 0, 0, 0, 0, 0, 0}; if (fq < 2) uf[mt] = *(const bf16x8*)(Ub + t * S5W + 8 * fq);
            usk[mt] = *(const u32x2*)(Ub + t * S5W + 4 * fq); }
        for (int sc = 0; sc < 16; ++sc) {
            const int tb = sc * 256 + 32 * w;
#pragma unroll
            for (int mt = 0; mt < 2; ++mt)
#pragma unroll
                for (int nt = 0; nt < 4; ++nt) {
                    const f32x4 z4 = (f32x4){0.f, 0.f, 0.f, 0.f};
                    const f32x4 dre = __builtin_amdgcn_mfma_f32_16x16x32_bf16(bfr[nt], uf[mt], z4, 0, 0, 0);
                    const f32x4 dim = __builtin_amdgcn_mfma_f32_16x16x32_bf16(bfr[4 + nt], uf[mt], z4, 0, 0, 0);
                    u32x4 wv; wv.x = pg8::cvt_pk_bf16(dre[0], dim[0]); wv.y = pg8::cvt_pk_bf16(dre[1], dim[1]); wv.z = pg8::cvt_pk_bf16(dre[2], dim[2]); wv.w = pg8::cvt_pk_bf16(dre[3], dim[3]);
                    *(LAS u32x4*)(xs + (16 * mt + fr) * XS_PITCH + 16 * nt + 4 * fq) = wv;
                }
            const u32x2 usk_cur0 = usk[0], usk_cur1 = usk[1];
            if (sc + 1 < 16) {
#pragma unroll
                for (int mt = 0; mt < 2; ++mt) { const size_t t = (size_t)(tb + 256 + 16 * mt + fr);
                    if (fq < 2) uf[mt] = *(const bf16x8*)(Ub + t * S5W + 8 * fq);
                    usk[mt] = *(const u32x2*)(Ub + t * S5W + 4 * fq); }
            }
            unsigned v[32];
#pragma unroll
            for (int t = 0; t < 32; ++t) v[t] = xs[t * XS_PITCH + lane];
            float sr = 0.f, si = 0.f;
#pragma unroll
            for (int t = 0; t < 32; ++t) { const float br = __uint_as_float(v[t] << 16), bi = __uint_as_float(v[t] & 0xffff0000u);
                const float nr = fmaf(-a.y, si, fmaf(a.x, sr, br)), ni = fmaf(a.y, sr, fmaf(a.x, si, bi)); sr = nr; si = ni; }
            carry[(sc & 1) * 512 + w * 64 + lane] = (f32x2){sr, si};
            __syncthreads();
            float cr = xr, ci = xi, mr = 0.f, mi = 0.f;
#pragma unroll
            for (int vv = 0; vv < 8; ++vv) { if (vv == w) { mr = cr; mi = ci; }
                const f32x2 e = carry[(sc & 1) * 512 + vv * 64 + lane];
                const float nr = fmaf(-aT.y, ci, fmaf(aT.x, cr, e.x)), ni = fmaf(aT.y, cr, fmaf(aT.x, ci, e.y)); cr = nr; ci = ni; }
            xr = cr; xi = ci;
            sr = mr; si = mi;
#pragma unroll
            for (int t = 0; t < 32; ++t) { const float br = __uint_as_float(v[t] << 16), bi = __uint_as_float(v[t] & 0xffff0000u);
                const float nr = fmaf(-a.y, si, fmaf(a.x, sr, br)), ni = fmaf(a.y, sr, fmaf(a.x, si, bi)); sr = nr; si = ni;
                xs[t * XS_PITCH + lane] = pg8::cvt_pk_bf16(sr, si); }
#pragma unroll
            for (int mt = 0; mt < 2; ++mt) {
                f32x4 d = (f32x4){0.f, 0.f, 0.f, 0.f};
#pragma unroll
                for (int ks = 0; ks < 4; ++ks) { const bf16x8 xf = *(const LAS bf16x8*)(xs + (16 * mt + fr) * XS_PITCH + 16 * ks + 4 * fq);
                    d = __builtin_amdgcn_mfma_f32_16x16x32_bf16(cfr[ks], xf, d, 0, 0, 0); }
                const u32x2 uu = mt ? usk_cur1 : usk_cur0;
                float y[4];
#pragma unroll
                for (int j = 0; j < 4; ++j) { const unsigned wd = uu[j >> 1]; const float uval = __uint_as_float((j & 1) ? (wd & 0xffff0000u) : (wd << 16));
                    const float yy = d[j] + dsk[j] * uval; const float zz = 1.5957691216f * (yy + 0.044715f * yy * yy * yy);
                    y[j] = yy * __builtin_amdgcn_rcpf(1.0f + __expf(-zz)); }
                u32x2 o; o.x = pg8::cvt_pk_bf16(y[0], y[1]); o.y = pg8::cvt_pk_bf16(y[2], y[3]);
                __builtin_nontemporal_store(o, (u32x2*)(Yb + (size_t)(tb + 16 * mt + fr) * S5W + 4 * fq));
            }
        }
    }
    __syncthreads();
}

__device__ __forceinline__ float half_sum(float v) {
    v += dpp_mov<0xB1>(v); v += dpp_mov<0x4E>(v); v += dpp_mov<0x141>(v); v += dpp_mov<0x140>(v);
    v += __shfl_xor(v, 16);
    return v;
}
__device__ __forceinline__ void conv_phase(const Args& A, int G) {
    const int tid = threadIdx.x, lane = tid & 63, wave = __builtin_amdgcn_readfirstlane(tid >> 6);
    unsigned char* ws = A.ws;
    const bf16* Z = (const bf16*)(ws + WS_Z); bf16* YM = (bf16*)(ws + WS_YM);
    const int gw = blockIdx.x * NWAVES + wave, NGW = G * NWAVES;
    constexpr int TT = 16, NTILE = 4, SEGT = TT * NTILE;
    for (int item = gw; item < BATCH * 4 * (SEQ / SEGT); item += NGW) {
        const int blk = item >> 3, wv_ = item & 7, b = blk & (BATCH - 1), idx = ((blk >> 3) << 3) + wv_;
        const int seg = idx & (SEQ / SEGT - 1), hp = (idx >> 6) & 3, ch0 = hp * 128 + 2 * lane;
        f32x2 wk[CK];
#pragma unroll
        for (int k = 0; k < CK; ++k) wk[k] = *(const f32x2*)(A.in[17] + k * CVW + ch0);
        const f32x2 bias = *(const f32x2*)(A.in[18] + ch0), lg = *(const f32x2*)(A.in[19] + ch0), lb = *(const f32x2*)(A.in[20] + ch0);
        const bf16* zp = Z + (size_t)b * (SEQ * CVW + SK512) + hp * 128;
        bf16* op = YM + (size_t)b * (SEQ * DM + SK1024) + 512 + hp * 128;
        const int t0 = seg * SEGT;
        f32x2 wp[30 + TT];
#pragma unroll
        for (int i = 0; i < 30; ++i) wp[i] = (f32x2){0.f, 0.f};
        if (t0 > 0) {
#pragma unroll
            for (int i = 0; i < 30; ++i) { const unsigned wv = __builtin_nontemporal_load(&((const unsigned*)(zp + (size_t)(t0 - 30 + i) * CVW))[lane]);
                wp[i] = (f32x2){__uint_as_float(wv << 16), __uint_as_float(wv & 0xffff0000u)}; }
        }
#pragma unroll 1
        for (int tt = 0; tt < NTILE; ++tt) {
            const int tb = t0 + TT * tt;
#pragma unroll
            for (int i = 0; i < TT; ++i) { const unsigned wv = __builtin_nontemporal_load(&((const unsigned*)(zp + (size_t)(tb + i) * CVW))[lane]);
                wp[30 + i] = (f32x2){__uint_as_float(wv << 16), __uint_as_float(wv & 0xffff0000u)}; }
#pragma unroll
            for (int i = 0; i < TT; ++i) {
                f32x2 acc = bias;
#pragma unroll
                for (int k = 0; k < CK; ++k) acc = __builtin_elementwise_fma(wk[k], wp[i + k], acc);
                const float s1 = half_sum(acc.x + acc.y), s2 = half_sum(fmaf(acc.x, acc.x, acc.y * acc.y));
                const float mean = s1 * (1.0f / 64.0f);
                const float var = fmaxf(s2 * (1.0f / 64.0f) - mean * mean, 0.0f);
                const float rstd = __builtin_amdgcn_rsqf(var + EPS);
                const f32x2 zn = (acc - mean) * rstd * lg + lb;
                f32x2 y; y.x = zn.x * __builtin_amdgcn_rcpf(1.0f + __expf(-zn.x)); y.y = zn.y * __builtin_amdgcn_rcpf(1.0f + __expf(-zn.y));
                __builtin_nontemporal_store(pg8::cvt_pk_bf16(y.x, y.y), &((unsigned*)(op + (size_t)(tb + i) * DM))[lane]);
            }
#pragma unroll
            for (int i = 0; i < 30; ++i) wp[i] = wp[TT + i];
        }
    }
}

__device__ __forceinline__ void final_phase(const Args& A, int G, int ssi = 3) {
    const int tid = threadIdx.x, lane = tid & 63, wave = __builtin_amdgcn_readfirstlane(tid >> 6);
    const float* ss4 = (const float*)(A.ws + WS_SS) + ssi * MTOK;
    const int gw = blockIdx.x * NWAVES + wave, NGW = G * NWAVES;
    f32x4 gv[4];
#pragma unroll
    for (int j = 0; j < 4; ++j) gv[j] = ((const f32x4*)A.in[26])[64 * j + lane];
    const bf16* XBf = (const bf16*)(A.ws + WS_XB);
    const bool xmap = (G == 256);
    const int xq = blockIdx.x & 7, jq = (blockIdx.x >> 3) * NWAVES + wave;
    for (int it = 0; it < (xmap ? 4 : 0x7fffffff); ++it) {
        const int row = xmap ? (4096 * xq + 1024 * it + 4 * jq) : (4 * gw + it * 4 * NGW);
        if (row >= MTOK) break;
        u32x2 w[4][4]; float rs[4];
#pragma unroll
        for (int r = 0; r < 4; ++r) { const u32x2* xi = (const u32x2*)(XBf + (size_t)(row + r) * DM) + lane; rs[r] = ss4[row + r];
#pragma unroll
            for (int j = 0; j < 4; ++j) w[r][j] = __builtin_nontemporal_load(&xi[64 * j]); }
#pragma unroll
        for (int r = 0; r < 4; ++r) { const float rr = __builtin_amdgcn_rsqf(rs[r] * (1.0f / 1024.0f) + EPS);
            f32x4* o = (f32x4*)(A.out + (size_t)(row + r) * DM) + lane;
#pragma unroll
            for (int j = 0; j < 4; ++j) { const u32x2 ww = w[r][j];
                const f32x4 v = (f32x4){__uint_as_float(ww.x << 16), __uint_as_float(ww.x & 0xffff0000u), __uint_as_float(ww.y << 16), __uint_as_float(ww.y & 0xffff0000u)};
                __builtin_nontemporal_store(v * rr * gv[j], &o[64 * j]); } }
    }
}


#define GAS __attribute__((address_space(1)))
constexpr size_t WS_CTL = 0, CTL_ZERO_BYTES = 65536;
constexpr int MISC_OFF = 131072 + 320;
#define XB_TMO      128
#define XB_XCNT(j)  (256  + 64 * (j))
#define XB_XSUB(j)  (1280 + 64 * (j))
#define XB_XGEN(j)  (2304 + 64 * (j))
#define XB_TOP      3328
#define XB_TOPGEN   3392
#define XCD_BAR_WORDS 3456
#define XB_SPIN_CAP (1u << 18)

__device__ __forceinline__ unsigned xb_ld(unsigned* p)              { return __hip_atomic_load(p, __ATOMIC_RELAXED, __HIP_MEMORY_SCOPE_AGENT); }
__device__ __forceinline__ unsigned xb_add(unsigned* p, unsigned v) { return __hip_atomic_fetch_add(p, v, __ATOMIC_RELAXED, __HIP_MEMORY_SCOPE_AGENT); }
__device__ __forceinline__ unsigned xb_xcc_id() { return (unsigned)__builtin_amdgcn_s_getreg((3 << 11) | 20) & 0xFu; }
#define XB_SPIN(cond, bar) do { unsigned _sp = 0; while (cond) { __builtin_amdgcn_s_sleep(1); \
    if ((++_sp & 255u) == 0u) { if (xb_ld(&(bar)[XB_TMO])) break; if (_sp > XB_SPIN_CAP) { atomicAdd(&(bar)[XB_TMO], 1u); break; } } } } while (0)

struct XcdBarrier {
    unsigned* bar; unsigned x;
    volatile LAS unsigned* st;
};

__device__ __forceinline__ XcdBarrier xcd_barrier_post(unsigned* bar, volatile LAS unsigned* st) {
    XcdBarrier b; b.bar = bar; b.x = xb_xcc_id(); b.st = st;
    if (threadIdx.x == 0) (void)xb_add(&bar[XB_XCNT(b.x)], 1u);
    return b;
}
__device__ __forceinline__ void xcd_barrier_complete(unsigned* bar, unsigned x, unsigned& nloc, unsigned& nx) {
    const unsigned G = gridDim.x * gridDim.y * gridDim.z;
    unsigned sum, cnt, mine, sp = 0u;
    for (;;) {
        sum = 0u; cnt = 0u; mine = 0u;
#pragma unroll
        for (unsigned j = 0; j < 16; ++j) { const unsigned c = xb_ld(&bar[XB_XCNT(j)]); sum += c; cnt += (c > 0u) ? 1u : 0u; mine = (j == x) ? c : mine; }
        if (sum == G) break;
        __builtin_amdgcn_s_sleep(1);
        if ((++sp & 255u) == 0u) { if (xb_ld(&bar[XB_TMO])) break; if (sp > XB_SPIN_CAP) { atomicAdd(&bar[XB_TMO], 1u); break; } }
    }
    nloc = mine > 0u ? mine : 1u; nx = cnt > 0u ? cnt : 1u;
}

__device__ __forceinline__ void xcd_barrier(const XcdBarrier& b) {
    asm volatile("s_waitcnt vmcnt(0)" ::: "memory");
    __syncthreads();
    if (threadIdx.x == 0) {
        unsigned* bar = b.bar;
        __builtin_amdgcn_s_waitcnt(0);
        unsigned nloc = b.st[0], nx = b.st[1];
        if (nloc == 0u) { xcd_barrier_complete(bar, b.x, nloc, nx); b.st[0] = nloc; b.st[1] = nx; }
        const unsigned old = xb_add(&bar[XB_XSUB(b.x)], 1u);
        const unsigned gen = old / nloc;
        if (old + 1u == (gen + 1u) * nloc) {
            __builtin_amdgcn_fence(__ATOMIC_RELEASE, "agent");
            asm volatile("s_waitcnt vmcnt(0)" ::: "memory");
            const unsigned og = xb_add(&bar[XB_TOP], 1u);
            const unsigned tg = og / nx;
            if (og + 1u == (tg + 1u) * nx) xb_add(&bar[XB_TOPGEN], 1u);
            else XB_SPIN(xb_ld(&bar[XB_TOPGEN]) == tg, bar);
            __builtin_amdgcn_fence(__ATOMIC_ACQUIRE, "agent");
            xb_add(&bar[XB_XGEN(b.x)], 1u);
            asm volatile("s_waitcnt vmcnt(0)" ::: "memory");
        } else {
            XB_SPIN(xb_ld(&bar[XB_XGEN(b.x)]) == gen, bar);
            __builtin_amdgcn_fence(__ATOMIC_ACQUIRE, "agent");
            asm volatile("s_waitcnt vmcnt(0)" ::: "memory");
        }
    }
    __syncthreads();
}

#define LB_MASK(j) (4096 + 64 * (j))
#define LB_SUB(j)  (5120 + 64 * (j))
#define LB_GEN(j)  (6144 + 64 * (j))
__device__ __forceinline__ void xcc_local_barrier(const XcdBarrier& b) {
    asm volatile("s_waitcnt vmcnt(0)" ::: "memory");
    __syncthreads();
    if (threadIdx.x == 0) {
        unsigned* bar = b.bar;
        __builtin_amdgcn_s_waitcnt(0);
        const unsigned old = xb_add(&bar[LB_SUB(b.x)], 1u);
        const unsigned gen = old / 32u;
        if (old + 1u == (gen + 1u) * 32u) xb_add(&bar[LB_GEN(b.x)], 1u);
        else XB_SPIN(xb_ld(&bar[LB_GEN(b.x)]) == gen, bar);
        __builtin_amdgcn_fence(__ATOMIC_ACQUIRE, "agent");
        asm volatile("s_waitcnt vmcnt(0)" ::: "memory");
    }
    __syncthreads();
}

__device__ __forceinline__ void dbg_dump(const Args& A, int G, const bf16* a, int lda, const bf16* b, int ldb) {
    const int gt = blockIdx.x * (NWAVES * 64) + threadIdx.x, NT = G * NWAVES * 64;
    for (size_t i = gt; i < (size_t)MTOK * DM; i += NT) { const size_t row = i >> 10; const int c = (int)(i & 1023);
        A.out[i] = (c < 512) ? bf2f(a[row * lda + c]) : bf2f(b[row * ldb + (c - 512)]); }
}
constexpr int N_PHASES = 10;
__global__ void __launch_bounds__(NWAVES * 64, 2) mk_fwd(Args args) {
    extern __shared__ __attribute__((aligned(16))) unsigned char lds_raw[];
    LAS unsigned char* lds = (LAS unsigned char*)lds_raw;
    const int G = gridDim.x, lo = args.ph_lo, hi = args.ph_hi;
    unsigned char* ws = args.ws;
    float* ss = (float*)(ws + WS_SS);
    bf16* XB = (bf16*)(ws + WS_XB); bf16* A1 = (bf16*)(ws + WS_A1);
#if MK_MULTI
#define GRID_SYNC() do { } while (0)
#define LOCAL_SYNC() do { } while (0)
#else
    volatile LAS unsigned* MISC = (volatile LAS unsigned*)(lds + MISC_OFF);
    if (threadIdx.x < 32) MISC[threadIdx.x] = 0u;
    __syncthreads();
    XcdBarrier bar = xcd_barrier_post((unsigned*)(ws + WS_CTL), MISC + 8);
    if (threadIdx.x == 0) (void)__hip_atomic_fetch_or(&bar.bar[LB_MASK(bar.x)], 1u << (blockIdx.x & 7), __ATOMIC_RELAXED, __HIP_MEMORY_SCOPE_AGENT);
    bool local_ok = false;
#define GRID_SYNC() xcd_barrier(bar)
#define LOCAL_SYNC() do { if (local_ok) xcc_local_barrier(bar); else xcd_barrier(bar); } while (0)
#endif
#define IN(k) (lo <= (k) && (k) < hi)
    if (IN(0)) { prologue(lds, args, G); __syncthreads(); GRID_SYNC(); }
#if !MK_MULTI
    {
        if (threadIdx.x == 0) {
            unsigned okv = (G == 256) ? 1u : 0u, allm = 0u;
#pragma unroll
            for (unsigned j = 0; j < 16; ++j) { const unsigned cnt = xb_ld(&bar.bar[XB_XCNT(j)]), m = xb_ld(&bar.bar[LB_MASK(j)]);
                if (j < 8) { okv &= (cnt == 32u && m != 0u && (m & (m - 1u)) == 0u) ? 1u : 0u; allm |= m; } else okv &= (cnt == 0u) ? 1u : 0u; }
            okv &= (allm == 0xFFu) ? 1u : 0u;
            okv &= (bar.x < 8u && xb_ld(&bar.bar[LB_MASK(bar.x & 7u)]) == (1u << (blockIdx.x & 7))) ? 1u : 0u;
            MISC[12] = okv;
        }
        __syncthreads();
        local_ok = MISC[12] != 0u;
    }
#endif
    if (IN(1)) {
        pg8::Gemm g{XB, (const bf16*)(ws + WS_W1GU), MTOK, 2 * DFF, DM}; pg8::StaticOrder S; S.init(MTOK, 2 * DFF, G, (int)blockIdx.x, GU_WGM);
        pg8::EpiSwiGLU E{A1, DFF, ss};
        pg8::gemm_phase<pg8::EpiSwiGLU, pg8::StaticOrder, true, true>(lds, g, S, E);
        LOCAL_SYNC();
    }
    if (IN(2)) {
        pg8::Gemm g{A1, (const bf16*)(ws + WS_W1D), MTOK, DM, DFF}; pg8::StaticOrder S; S.init(MTOK, DM, G, (int)blockIdx.x, 8, 1);
        pg8::EpiResid E{XB, ss + MTOK, 0.5f};
        pg8::gemm_phase<pg8::EpiResid, pg8::StaticOrder, true, true>(lds, g, S, E);
        LOCAL_SYNC();
    }
#if DBG_STOP == 2
    if (IN(9)) final_phase(args, G, 1);
    return;
#endif
    if (IN(3)) {
        pg8::Gemm g{XB, (const bf16*)(ws + WS_WIN), MTOK, NIN, DM}; pg8::StaticOrder S; S.init(MTOK, NIN, G, (int)blockIdx.x);
        pg8::EpiWin E{(bf16*)(ws + WS_U), (bf16*)(ws + WS_Z), ss + MTOK};
        pg8::gemm_phase<pg8::EpiWin, pg8::StaticOrder, true, true>(lds, g, S, E);
        LOCAL_SYNC();
    }
#if DBG_STOP == 3
    if (IN(9)) dbg_dump(args, G, (const bf16*)(ws + WS_U), 512, (const bf16*)(ws + WS_Z), 512);
    return;
#endif
    if (IN(4)) { s5_phase(lds, args, G); conv_phase(args, G); LOCAL_SYNC(); }
#if DBG_STOP == 4
    if (IN(9)) dbg_dump(args, G, (const bf16*)(ws + WS_YS), 512, (const bf16*)(ws + WS_YM) + 512, 1024);
    return;
#endif
    if (IN(5)) {
        pg8::Gemm g{(const bf16*)(ws + WS_YS), (const bf16*)(ws + WS_WGLU), MTOK, S5W, S5W, SK512 * 2}; pg8::StaticOrder S; S.init(MTOK, S5W, G, (int)blockIdx.x);
        pg8::EpiGlu E{(const bf16*)(ws + WS_YS), (bf16*)(ws + WS_YM), args.in[16]};
        pg8::gemm_phase<pg8::EpiGlu, pg8::StaticOrder, true, true>(lds, g, S, E);
        LOCAL_SYNC();
    }
    if (IN(6)) {
        pg8::Gemm g{(const bf16*)(ws + WS_YM), (const bf16*)(ws + WS_WOUT), MTOK, DM, DM, SK1024 * 2}; pg8::StaticOrder S; S.init(MTOK, DM, G, (int)blockIdx.x);
        pg8::EpiResid E{XB, ss + 2 * MTOK, 1.0f};
        pg8::gemm_phase<pg8::EpiResid, pg8::StaticOrder, true, true>(lds, g, S, E);
        LOCAL_SYNC();
    }
#if DBG_STOP == 6
    if (IN(9)) final_phase(args, G, 2);
    return;
#endif
    if (IN(7)) {
        pg8::Gemm g{XB, (const bf16*)(ws + WS_W2GU), MTOK, 2 * DFF, DM}; pg8::StaticOrder S; S.init(MTOK, 2 * DFF, G, (int)blockIdx.x, GU_WGM);
        pg8::EpiSwiGLU E{A1, DFF, ss + 2 * MTOK};
        pg8::gemm_phase<pg8::EpiSwiGLU, pg8::StaticOrder, true, true>(lds, g, S, E);
        LOCAL_SYNC();
    }
    if (IN(8)) {
        pg8::Gemm g{A1, (const bf16*)(ws + WS_W2D), MTOK, DM, DFF}; pg8::StaticOrder S; S.init(MTOK, DM, G, (int)blockIdx.x, 8, 1);
        pg8::EpiResid E{XB, ss + 3 * MTOK, 0.5f};
        pg8::gemm_phase<pg8::EpiResid, pg8::StaticOrder, true, true>(lds, g, S, E);
        LOCAL_SYNC();
    }
    if (IN(9)) final_phase(args, G);
#undef IN
}

extern "C" void kernel_launch(void* const* d_in, const int* in_sizes, int n_in, void* d_out, int out_size, void* d_ws, size_t ws_size, hipStream_t stream) {
    static int grid = 0;
    if (grid == 0) {
        if (n_in != 27 || out_size != MTOK * DM || ws_size < WS_END) { fprintf(stderr, "kernel_launch: unexpected shapes (n_in %d out %d ws %zu)\n", n_in, out_size, ws_size); grid = -1; return; }
        int dev = 0, cus = 0, per_cu = 0;
        hipGetDevice(&dev); hipDeviceGetAttribute(&cus, hipDeviceAttributeMultiprocessorCount, dev);
        if (hipFuncSetAttribute((const void*)mk_fwd, hipFuncAttributeMaxDynamicSharedMemorySize, LDS_BYTES) != hipSuccess) { fprintf(stderr, "kernel_launch: hipFuncSetAttribute failed\n"); grid = -1; return; }
        if (hipOccupancyMaxActiveBlocksPerMultiprocessor(&per_cu, (const void*)mk_fwd, NWAVES * 64, LDS_BYTES) != hipSuccess || per_cu < 1) { fprintf(stderr, "kernel_launch: occupancy query says %d\n", per_cu); per_cu = 1; }
        (void)hipGetLastError();
        grid = cus;
    }
    if (grid < 0) return;
    Args a{};
    for (int i = 0; i < 27; ++i) a.in[i] = (const float*)d_in[i];
    a.out = (float*)d_out; a.ws = (unsigned char*)d_ws;
#if MK_MULTI
    for (int p = 0; p < N_PHASES; ++p) { a.ph_lo = p; a.ph_hi = p + 1; hipLaunchKernelGGL(mk_fwd, dim3(grid), dim3(NWAVES * 64), LDS_BYTES, stream, a); }
#else
    a.ph_lo = 0; a.ph_hi = N_PHASES;
    if (hipMemsetAsync((char*)d_ws + WS_CTL, 0, CTL_ZERO_BYTES, stream) != hipSuccess) { fprintf(stderr, "kernel_launch: hipMemsetAsync failed\n"); return; }
    void* kargs[] = {&a};
    hipError_t e = hipLaunchCooperativeKernel((const void*)mk_fwd, dim3(grid), dim3(NWAVES * 64), kargs, LDS_BYTES, stream);
    if (e != hipSuccess) fprintf(stderr, "kernel_launch: cooperative launch failed: %s (grid %d)\n", hipGetErrorString(e), grid);
#endif
}
```
